# Optimizing an MI355X kernel written in HIP

```python
import jax, jax.numpy as jnp
from jax import lax
import numpy as np

D_MODEL = 4096
BATCH = 1
SEQ = 8192
DEPTH = 1

CTX_LEN = 256
GRID_W = 64
MIX_WIDTH = D_MODEL
A_WIDTH = MIX_WIDTH // 2
A_GROUPS = 16
A_GROUP_DIM = A_WIDTH // A_GROUPS
CHUNK = 128
B_WIDTH = MIX_WIDTH - A_WIDTH
HEAD_DIM = 128
N_HEADS = B_WIDTH // HEAD_DIM
N_KV_HEADS = 4
KV_GROUP = N_HEADS // N_KV_HEADS
KV_WIDTH = N_KV_HEADS * HEAD_DIM
Q_BLOCK = 128
ROPE_THETA = 10000.0
D_FF = 11008
CONV_W = 3
EPS = 1e-6
N_MOD = 6
IN_COLS = 2 * A_WIDTH + B_WIDTH + 2 * KV_WIDTH
SPLITS = (2 * A_WIDTH, 2 * A_WIDTH + B_WIDTH, 2 * A_WIDTH + B_WIDTH + KV_WIDTH)

kernel_name = 'hybrid_gmlp_gqa_dit_block'


def rms_norm(x, g):
    xf = x.astype(jnp.float32)
    y = xf * lax.rsqrt(jnp.mean(xf * xf, axis=-1, keepdims=True) + EPS)
    return (y * g.astype(jnp.float32)).astype(x.dtype)


def layer_norm(x, g, b):
    xf = x.astype(jnp.float32)
    mu = jnp.mean(xf, axis=-1, keepdims=True)
    var = jnp.mean(jnp.square(xf - mu), axis=-1, keepdims=True)
    y = (xf - mu) * lax.rsqrt(var + EPS)
    return (y * g.astype(jnp.float32) + b.astype(jnp.float32)).astype(x.dtype)


def modulate(xn, shift, scale):
    return xn * (1 + scale) + shift


def adaln(cond, w_ada, b_ada, n):
    m = jax.nn.silu(cond) @ w_ada[:, :n * D_MODEL] + b_ada[:n * D_MODEL]
    return jnp.split(m, n, axis=-1)


def split_heads(t, n):
    return t.reshape(t.shape[0], t.shape[1], n, HEAD_DIM)


def rope_axis(x, pos):
    half = x.shape[-1] // 2
    freqs = ROPE_THETA ** (-jnp.arange(half, dtype=jnp.float32) / half)
    ang = pos.astype(jnp.float32)[:, None] * freqs[None, :]
    cos = jnp.cos(ang)[:, None, :]
    sin = jnp.sin(ang)[:, None, :]
    xf = x.astype(jnp.float32)
    x1, x2 = xf[..., :half], xf[..., half:]
    return jnp.concatenate([x1 * cos - x2 * sin, x2 * cos + x1 * sin], axis=-1).astype(x.dtype)


def axial_rope(x, row, col):
    h = x.shape[-1] // 2
    return jnp.concatenate([rope_axis(x[..., :h], row), rope_axis(x[..., h:], col)], axis=-1)


def chunk_mlp(z, ln_g, ln_b, w_s, b_s):
    bsz, L, _ = z.shape
    z = jax.nn.gelu(z, approximate=False)
    u, v = jnp.split(z, 2, axis=-1)
    v = layer_norm(v, ln_g, ln_b).reshape(bsz, L // CHUNK, CHUNK, A_GROUPS, A_GROUP_DIM)
    mixed = jnp.einsum('gpq,bnqgc->bnpgc', w_s, v) + b_s.T[:, :, None]
    return u * mixed.reshape(bsz, L, A_WIDTH)


def attend(qi, k, v):
    s = jnp.einsum('bqkgd,bskd->bkgqs', qi, k).astype(jnp.float32) * (HEAD_DIM ** -0.5)
    p = jax.nn.softmax(s, axis=-1).astype(v.dtype)
    return jnp.einsum('bkgqs,bskd->bqkgd', p, v)


def latent_attention(q, k_all, v_all):
    bsz, S = q.shape[:2]
    qb = q.reshape(bsz, S // Q_BLOCK, Q_BLOCK, N_KV_HEADS, KV_GROUP, HEAD_DIM).transpose(1, 0, 2, 3, 4, 5)
    o = lax.map(lambda qi: attend(qi, k_all, v_all), qb)
    return o.transpose(1, 0, 2, 3, 4, 5).reshape(bsz, S, B_WIDTH)


def merge_mixers(out_a, out_b, g_out_a, g_out_b, w_out):
    return jnp.concatenate([rms_norm(out_a, g_out_a), rms_norm(out_b, g_out_b)], axis=-1) @ w_out


def depthwise_conv(h, w, b):
    L = h.shape[1]
    pad = CONV_W // 2
    hp = jnp.pad(h, ((0, 0), (pad, pad), (0, 0)))
    return sum(hp[:, j:j + L] * w[j] for j in range(CONV_W)) + b


def ffn_sublayer(x, g_pre, g_post, shift, scale, gate, w_up, conv_w, conv_b, w_down):
    h = modulate(rms_norm(x, g_pre), shift, scale)
    a = depthwise_conv(h @ w_up, conv_w, conv_b)
    gt, up = jnp.split(a, 2, axis=-1)
    f = (jax.nn.silu(gt) * up) @ w_down
    return x + gate * rms_norm(f, g_post)


def setup_inputs(seed: int = 0) -> dict:
    key = jax.random.key(seed)
    ks = jax.random.split(key, 28)
    f32 = jnp.float32

    def nrm(k, shape, scale):
        return jax.random.normal(k, shape, f32) * scale

    def gain(k, shape):
        return 1.0 + 0.05 * jax.random.normal(k, shape, f32)

    L = DEPTH
    return {
        'x': nrm(ks[0], (BATCH, SEQ, D_MODEL), 1.0),
        'c': nrm(ks[1], (BATCH, D_MODEL), 1.0),
        'ctx': nrm(ks[2], (BATCH, CTX_LEN, D_MODEL), 1.0),
        'c_ctx': nrm(ks[3], (D_MODEL,), 1.0),
        'w_ada': nrm(ks[4], (L, D_MODEL, N_MOD * D_MODEL), 0.5 * D_MODEL ** -0.5),
        'b_ada': nrm(ks[5], (L, N_MOD * D_MODEL), 0.02),
        'g_pre_mix': gain(ks[6], (L, D_MODEL)),
        'g_post_mix': gain(ks[7], (L, D_MODEL)),
        'g_pre_ffn': gain(ks[8], (L, D_MODEL)),
        'g_post_ffn': gain(ks[9], (L, D_MODEL)),
        'w_in': nrm(ks[10], (L, D_MODEL, IN_COLS), D_MODEL ** -0.5),
        'ln_v_g': gain(ks[11], (L, A_WIDTH)),
        'ln_v_b': nrm(ks[12], (L, A_WIDTH), 0.02),
        'w_s': nrm(ks[13], (L, A_GROUPS, CHUNK, CHUNK), CHUNK ** -0.5),
        'b_s': gain(ks[14], (L, A_GROUPS, CHUNK)),
        'g_q': gain(ks[15], (L, HEAD_DIM)),
        'g_k': gain(ks[16], (L, HEAD_DIM)),
        'g_out_a': gain(ks[17], (L, A_WIDTH)),
        'g_out_b': gain(ks[18], (L, B_WIDTH)),
        'w_out': nrm(ks[19], (L, MIX_WIDTH, D_MODEL), MIX_WIDTH ** -0.5),
        'w_up': nrm(ks[20], (L, D_MODEL, 2 * D_FF), D_MODEL ** -0.5),
        'conv_w': nrm(ks[21], (L, CONV_W, 2 * D_FF), CONV_W ** -0.5),
        'conv_b': nrm(ks[22], (L, 2 * D_FF), 0.02),
        'w_down': nrm(ks[23], (L, D_FF, D_MODEL), D_FF ** -0.5),
    }


def reference(x, c, ctx, c_ctx, w_ada, b_ada, g_pre_mix, g_post_mix, g_pre_ffn, g_post_ffn,
              w_in, ln_v_g, ln_v_b, w_s, b_s, g_q, g_k, g_out_a, g_out_b, w_out,
              w_up, conv_w, conv_b, w_down):
    bsz, S, _ = x.shape
    C = ctx.shape[1]
    ROWS = S // GRID_W
    row = jnp.broadcast_to(jnp.arange(ROWS, dtype=jnp.int32)[:, None], (ROWS, GRID_W)).reshape(-1)
    col = jnp.broadcast_to(jnp.arange(GRID_W, dtype=jnp.int32)[None, :], (ROWS, GRID_W)).reshape(-1)

    for l in range(DEPTH):
        last = l == DEPTH - 1
        sh_a, sc_a, gt_a, sh_f, sc_f, gt_f = [m[:, None, :] for m in adaln(c, w_ada[l], b_ada[l], N_MOD)]
        cmods = adaln(c_ctx, w_ada[l], b_ada[l], 2 if last else N_MOD)

        h = modulate(rms_norm(x, g_pre_mix[l]), sh_a, sc_a)
        hc = modulate(rms_norm(ctx, g_pre_mix[l]), cmods[0], cmods[1])

        za, q, k, v = jnp.split(h @ w_in[l], SPLITS, axis=-1)
        q = axial_rope(rms_norm(split_heads(q, N_HEADS), g_q[l]), row, col)
        k = axial_rope(rms_norm(split_heads(k, N_KV_HEADS), g_k[l]), row, col)
        v = split_heads(v, N_KV_HEADS)
        if last:
            kc, vc = jnp.split(hc @ w_in[l][:, SPLITS[1]:], 2, axis=-1)
        else:
            zac, qc, kc, vc = jnp.split(hc @ w_in[l], SPLITS, axis=-1)
        kc = rms_norm(split_heads(kc, N_KV_HEADS), g_k[l])
        vc = split_heads(vc, N_KV_HEADS)
        k_all = jnp.concatenate([kc, k], axis=1)
        v_all = jnp.concatenate([vc, v], axis=1)

        out_a = chunk_mlp(za, ln_v_g[l], ln_v_b[l], w_s[l], b_s[l])
        out_b = latent_attention(q, k_all, v_all)
        o = merge_mixers(out_a, out_b, g_out_a[l], g_out_b[l], w_out[l])
        x_mix = x + gt_a * rms_norm(o, g_post_mix[l])

        if not last:
            out_ac = chunk_mlp(zac, ln_v_g[l], ln_v_b[l], w_s[l], b_s[l])
            qc = rms_norm(split_heads(qc, N_HEADS), g_q[l])
            out_bc = attend(qc.reshape(bsz, C, N_KV_HEADS, KV_GROUP, HEAD_DIM), kc, vc).reshape(bsz, C, B_WIDTH)
            oc = merge_mixers(out_ac, out_bc, g_out_a[l], g_out_b[l], w_out[l])
            ctx_mix = ctx + cmods[2] * rms_norm(oc, g_post_mix[l])
            ctx = ffn_sublayer(ctx_mix, g_pre_ffn[l], g_post_ffn[l], cmods[3], cmods[4], cmods[5],
                               w_up[l], conv_w[l], conv_b[l], w_down[l])

        x = ffn_sublayer(x_mix, g_pre_ffn[l], g_post_ffn[l], sh_f, sc_f, gt_f,
                         w_up[l], conv_w[l], conv_b[l], w_down[l])
    return x
```

```cpp
#include <hip/hip_runtime.h>
#include <cstdio>
#include <cstdint>
__device__ __forceinline__ int lane_id() { const int l = (int)__builtin_amdgcn_mbcnt_hi(~0u, __builtin_amdgcn_mbcnt_lo(~0u, 0u)); __builtin_assume(l >= 0 && l < 64); return l; }
namespace pg8 {
#define PG8_LAS __attribute__((address_space(3)))
typedef unsigned short bf16_t;
typedef short bf16x8 __attribute__((ext_vector_type(8)));
typedef float f32x4 __attribute__((ext_vector_type(4)));
typedef unsigned u32x4 __attribute__((ext_vector_type(4)));
constexpr int BM = 256, BK = 64, HALF = 128, HTB = HALF * BK * 2  , STAGE_BYTES = 8 * HTB, NXCD = 8, WGM = 8;

__host__ __device__ __forceinline__ int lds_byte(int r, int c) { const int st = (r >> 4) * 2 + (c >> 5), rr = r & 15, cc = c & 31, ob = rr * 64 + cc * 2; return st * 1024 + (ob ^ (((ob >> 9) & 1) << 5)); }
__host__ __device__ __forceinline__ void stage_rc(int b, int& R, int& C) { const int st = b / 1024, sb = b % 1024, swz = sb ^ (((sb >> 9) & 1) << 5); R = (st >> 1) * 16 + swz / 64; C = (st & 1) * 32 + (swz % 64) / 2; }
__host__ __device__ __forceinline__ int perm32(int rho) { const int n = rho >> 4, i = rho & 15; return 8 * (i >> 2) + 4 * n + (i & 3); }

struct Unit { int pm, pn; };
struct Gemm { const bf16_t* A; const bf16_t* Bt; int M, N, K; };

struct StaticOrder {
    int nM, nN, nwg, G, c;
    __host__ __device__ void init(int M, int N, int G_, int c_) { nM = M / BM; nN = N / BM; nwg = nM * nN; G = G_; c = c_; }
    __host__ __device__ bool next(int i, Unit& u) const {
        const long L = (long)i * G + c; if (L >= nwg) return false;
        int wgid = (int)L; { const int q = nwg / NXCD, r = nwg % NXCD, xcd = wgid % NXCD, off = wgid / NXCD; wgid = (xcd < r ? xcd * (q + 1) : r * (q + 1) + (xcd - r) * q) + off; }
        const int nig = WGM * nN, gid = wgid / nig, fm = gid * WGM, gsz = (nM - fm) < WGM ? (nM - fm) : WGM;
        u.pm = fm + ((wgid % nig) % gsz); u.pn = (wgid % nig) / gsz; return true;
    }
    __device__ __forceinline__ void a_ready(const Unit&) const {}
    __device__ __forceinline__ void done(const Unit&) const {}
};

__device__ __forceinline__ unsigned cvt_pk_bf16(float lo, float hi) { unsigned r; asm volatile("v_cvt_pk_bf16_f32 %0, %1, %2" : "=v"(r) : "v"(lo), "v"(hi)); return r; }
typedef float f32x2 __attribute__((ext_vector_type(2)));
__device__ __forceinline__ f32x2 gelu_pk(f32x2 v) {
    const f32x2 av = __builtin_elementwise_abs(v), d = av * 0.2316418882f + 1.0f;
    f32x2 t; t.x = __builtin_amdgcn_rcpf(d.x); t.y = __builtin_amdgcn_rcpf(d.y);
    f32x2 q = t * 0.5307027145f + (-0.7265760135f); q = q * t + 0.7107068705f; q = q * t + (-0.142248368f); q = q * t + 0.127414796f; q = q * t;
    const f32x2 s = (v * v) * (-0.72134752044f);
    f32x2 e; e.x = __builtin_amdgcn_exp2f(s.x); e.y = __builtin_amdgcn_exp2f(s.y);
    const f32x2 m = v * (q * e), r = v - m;
    f32x2 o; o.x = v.x < 0.f ? m.x : r.x; o.y = v.y < 0.f ? m.y : r.y; return o;
}

template <int ACT  > struct EpiBf16 {
    static constexpr bool PERM = true, AFTER_DRAIN = false; static_assert(ACT == 0 || ACT == 1, "EpiBf16: ACT is 0 (none) or 1 (gelu_pk)");
    bf16_t* O; int ldc; const float* bias; int split_cols; size_t split_stride; float scale0;
    __device__ __forceinline__ void operator()(const f32x4 (&acc)[2][2][4][2], const Unit& u, int wr, int wc, int fr, int fq) const {
        const int row0 = u.pm * BM + wr * 64 + fr; int colt = u.pn * BM; bf16_t* base = O;
        float sc = 1.f; if (split_cols) { const int t = colt / split_cols; base += (size_t)t * split_stride; colt -= t * split_cols; if (t == 0) sc = scale0; }
        const int col0 = colt + wc * 32 + 8 * fq, bcol0 = u.pn * BM + wc * 32 + 8 * fq;
        f32x4 bv[2][2];
#pragma unroll
        for (int bj = 0; bj < 2; ++bj)
#pragma unroll
            for (int n = 0; n < 2; ++n) bv[bj][n] = bias ? *(const f32x4*)(bias + bcol0 + bj * HALF + 4 * n) : (f32x4){0.f, 0.f, 0.f, 0.f};
#pragma unroll
        for (int ai = 0; ai < 2; ++ai)
#pragma unroll
            for (int m = 0; m < 4; ++m) { bf16_t* rowp = base + (size_t)(row0 + ai * HALF + m * 16) * ldc + col0;
#pragma unroll
                for (int bj = 0; bj < 2; ++bj) { f32x4 v0 = acc[ai][bj][m][0] + bv[bj][0], v1 = acc[ai][bj][m][1] + bv[bj][1];
                    if (ACT == 1) { f32x2 a = gelu_pk((f32x2){v0[0], v0[1]}), b = gelu_pk((f32x2){v0[2], v0[3]}), c = gelu_pk((f32x2){v1[0], v1[1]}), d = gelu_pk((f32x2){v1[2], v1[3]});
                        v0 = (f32x4){a.x, a.y, b.x, b.y}; v1 = (f32x4){c.x, c.y, d.x, d.y}; }
                    v0 = v0 * sc; v1 = v1 * sc; u32x4 w; w.x = cvt_pk_bf16(v0[0], v0[1]); w.y = cvt_pk_bf16(v0[2], v0[3]); w.z = cvt_pk_bf16(v1[0], v1[1]); w.w = cvt_pk_bf16(v1[2], v1[3]);
                    *(u32x4*)(rowp + bj * HALF) = w; } }
    }
};
struct EpiF32 {
    static constexpr bool PERM = false, AFTER_DRAIN = false;
    float* C; int ldc; const float* bias;
    __device__ __forceinline__ void operator()(const f32x4 (&acc)[2][2][4][2], const Unit& u, int wr, int wc, int fr, int fq) const {
        const int row0 = u.pm * BM + wr * 64 + fr, col0 = u.pn * BM + wc * 32 + 4 * fq;
        f32x4 bv[2][2];
#pragma unroll
        for (int bj = 0; bj < 2; ++bj)
#pragma unroll
            for (int n = 0; n < 2; ++n) bv[bj][n] = bias ? *(const f32x4*)(bias + col0 + bj * HALF + n * 16) : (f32x4){0.f, 0.f, 0.f, 0.f};
#pragma unroll
        for (int ai = 0; ai < 2; ++ai)
#pragma unroll
            for (int m = 0; m < 4; ++m) { float* rowp = C + (size_t)(row0 + ai * HALF + m * 16) * ldc + col0;
#pragma unroll
                for (int bj = 0; bj < 2; ++bj)
#pragma unroll
                    for (int n = 0; n < 2; ++n) *(f32x4*)(rowp + bj * HALF + n * 16) = acc[ai][bj][m][n] + bv[bj][n]; }
    }
};

template <class Epi, class Sched, bool ALIGN_EPI = false, bool SP2 = false>
__device__ __forceinline__ void gemm_phase(PG8_LAS unsigned char* lds, const Gemm g, const Sched& S, const Epi& E, const int wave_) {
    const int lane = lane_id(), wid = wave_; __builtin_assume(lane >= 0 && lane < 64); __builtin_assume(wid >= 0 && wid < 8);
  const int tid = wid * 64 + lane, wr = wid >> 2, wc = wid & 3, fr = lane & 15, fq = lane >> 4;
    const int K = g.K, nt = K / BK;
    unsigned voffA[2], voffB[2];
#pragma unroll
    for (int i = 0; i < 2; ++i) { int R, C; stage_rc(tid * 16 + i * 8192, R, C); const int Rb = Epi::PERM ? ((R & ~31) + perm32(R & 31)) : R;
        voffA[i] = (unsigned)(R * K + C) * 2u; voffB[i] = (unsigned)(Rb * K + C) * 2u; }
    const size_t kstep = (size_t)(BK * 2);
    const size_t hstep = (size_t)HALF * K * 2;
    const size_t tstep = 2 * hstep;
    const unsigned ldsw = (unsigned)wid * 1024u;
    const int aoff = lds_byte(wr * 64 + fr, fq * 8), boff = lds_byte(wc * 32 + fr, fq * 8);
#define PG8_SA(b, h) (((b) * 2 + (h)) * HTB)
#define PG8_SB(b, h) ((4 + (b) * 2 + (h)) * HTB)
#define PG8_STAGE(bufoff, gbase, voff) do { _Pragma("unroll") for (int _i = 0; _i < 2; ++_i) \
        __builtin_amdgcn_global_load_lds((const unsigned*)((const char*)(gbase) + (voff)[_i]), (PG8_LAS unsigned*)(lds + (bufoff) + ldsw + _i * 8192), 16, 0, 0); } while (0)
#define PG8_LDA(dst, b, h) do { _Pragma("unroll") for (int m = 0; m < 4; ++m) _Pragma("unroll") for (int k = 0; k < 2; ++k) dst[m][k] = *(const PG8_LAS bf16x8*)(lds + PG8_SA(b, h) + aoff + m * 2048 + k * 1024); } while (0)
#define PG8_LDB(dst, b, h) do { _Pragma("unroll") for (int n = 0; n < 2; ++n) _Pragma("unroll") for (int k = 0; k < 2; ++k) dst[n][k] = *(const PG8_LAS bf16x8*)(lds + PG8_SB(b, h) + boff + n * 2048 + k * 1024); } while (0)
#define PG8_MMA(ai, bj, At, Bt) do { __builtin_amdgcn_s_setprio(1); _Pragma("unroll") for (int m = 0; m < 4; ++m) _Pragma("unroll") for (int n = 0; n < 2; ++n) _Pragma("unroll") for (int k = 0; k < 2; ++k) \
        acc[ai][bj][m][n] = __builtin_amdgcn_mfma_f32_16x16x32_bf16(Bt[n][k], At[m][k], acc[ai][bj][m][n], 0, 0, 0); __builtin_amdgcn_s_setprio(0); } while (0)
#define PG8_WAIT_V(n) asm volatile("s_waitcnt vmcnt(" #n ")" ::: "memory")
#define PG8_WAIT_L(n) asm volatile("s_waitcnt lgkmcnt(" #n ")" ::: "memory")
#define PG8_BAR __builtin_amdgcn_s_barrier()
#define PG8_SCHED __builtin_amdgcn_sched_barrier(0)
    Unit cur, nxt; int ui = 0;
    if (!S.next(0, cur)) return;
    f32x4 acc[2][2][4][2];
#pragma unroll
    for (int a = 0; a < 2; ++a)
#pragma unroll
        for (int b = 0; b < 2; ++b)
#pragma unroll
            for (int m = 0; m < 4; ++m)
#pragma unroll
                for (int n = 0; n < 2; ++n) acc[a][b][m][n] = (f32x4){0.f, 0.f, 0.f, 0.f};
    bf16x8 At[4][2], B0[2][2], B1[2][2];
    const char* cA = (const char*)g.A + (size_t)cur.pm * tstep; const char* cB = (const char*)g.Bt + (size_t)cur.pn * tstep;
    S.a_ready(cur);
    if constexpr (SP2) {
        PG8_STAGE(PG8_SB(0, 0), cB, voffB); PG8_STAGE(PG8_SB(0, 1), cB + hstep, voffB); PG8_STAGE(PG8_SA(0, 0), cA, voffA); PG8_STAGE(PG8_SA(0, 1), cA + hstep, voffA);
        if (wr == 1) PG8_BAR;
        PG8_WAIT_V(2); PG8_BAR;
        PG8_STAGE(PG8_SB(1, 0), cB + kstep, voffB); PG8_STAGE(PG8_SA(1, 0), cA + kstep, voffA); PG8_STAGE(PG8_SB(1, 1), cB + hstep + kstep, voffB);
        PG8_WAIT_V(6); PG8_BAR;
    } else {
        PG8_STAGE(PG8_SB(0, 0), cB, voffB); PG8_STAGE(PG8_SA(0, 0), cA, voffA); PG8_STAGE(PG8_SB(0, 1), cB + hstep, voffB); PG8_STAGE(PG8_SA(0, 1), cA + hstep, voffA);
        if (wr == 1) PG8_BAR;
        PG8_WAIT_V(4); PG8_BAR;
        PG8_STAGE(PG8_SB(1, 0), cB + kstep, voffB); PG8_STAGE(PG8_SA(1, 0), cA + kstep, voffA); PG8_STAGE(PG8_SB(1, 1), cB + hstep + kstep, voffB);
        PG8_WAIT_V(6); PG8_BAR;
    }
    for (;;) {
        const bool has_next = S.next(ui + 1, nxt);
        const char* nA = has_next ? (const char*)g.A + (size_t)nxt.pm * tstep : cA; const char* nB = has_next ? (const char*)g.Bt + (size_t)nxt.pn * tstep : cB;
        for (int t = 0; t < nt; t += 2) {
            const bool last = (t == nt - 2);
            const char* a1 = cA + (size_t)(t + 1) * kstep;
            const char* a2 = last ? nA : cA + (size_t)(t + 2) * kstep; const char* b2 = last ? nB : cB + (size_t)(t + 2) * kstep;
            const char* a3 = a2 + kstep; const char* b3 = b2 + kstep;
            if (last && has_next) S.a_ready(nxt);
            if constexpr (SP2) {
            PG8_LDB(B0, 0, 0); PG8_LDB(B1, 0, 1); PG8_SCHED; PG8_LDA(At, 0, 0); PG8_STAGE(PG8_SA(1, 1), a1 + hstep, voffA);
            PG8_WAIT_V(8); PG8_WAIT_L(0); PG8_BAR; PG8_MMA(0, 0, At, B0); PG8_MMA(0, 1, At, B1); PG8_BAR; PG8_SCHED;
            PG8_LDA(At, 0, 1); PG8_STAGE(PG8_SB(0, 0), b2, voffB); PG8_STAGE(PG8_SB(0, 1), b2 + hstep, voffB); PG8_STAGE(PG8_SA(0, 0), a2, voffA);
            PG8_WAIT_V(8); PG8_WAIT_L(0); PG8_BAR; PG8_MMA(1, 0, At, B0); PG8_MMA(1, 1, At, B1); PG8_BAR; PG8_SCHED;
            PG8_LDB(B0, 1, 0); PG8_LDB(B1, 1, 1); PG8_SCHED; PG8_LDA(At, 1, 0); PG8_STAGE(PG8_SA(0, 1), a2 + hstep, voffA);
            PG8_WAIT_V(8); PG8_WAIT_L(0); PG8_BAR; PG8_MMA(0, 0, At, B0); PG8_MMA(0, 1, At, B1); PG8_BAR; PG8_SCHED;
            PG8_LDA(At, 1, 1); PG8_STAGE(PG8_SB(1, 0), b3, voffB); PG8_STAGE(PG8_SB(1, 1), b3 + hstep, voffB); PG8_STAGE(PG8_SA(1, 0), a3, voffA);
            PG8_WAIT_V(8); PG8_WAIT_L(0); PG8_BAR; PG8_MMA(1, 0, At, B0); PG8_MMA(1, 1, At, B1); PG8_BAR; PG8_SCHED;
            } else {
            PG8_LDB(B0, 0, 0); PG8_SCHED; PG8_LDA(At, 0, 0); PG8_STAGE(PG8_SA(1, 1), a1 + hstep, voffA);
            PG8_WAIT_L(8); PG8_BAR; PG8_WAIT_L(0); PG8_MMA(0, 0, At, B0); PG8_BAR; PG8_SCHED;
            PG8_LDB(B1, 0, 1); PG8_STAGE(PG8_SB(0, 0), b2, voffB);
            PG8_BAR; PG8_WAIT_L(0); PG8_MMA(0, 1, At, B1); PG8_BAR;
            PG8_LDA(At, 0, 1); PG8_STAGE(PG8_SA(0, 0), a2, voffA);
            PG8_BAR; PG8_WAIT_L(0); PG8_MMA(1, 0, At, B0); PG8_BAR; PG8_SCHED;
            PG8_STAGE(PG8_SB(0, 1), b2 + hstep, voffB);
            PG8_WAIT_V(6); PG8_BAR; PG8_MMA(1, 1, At, B1); PG8_BAR;
            PG8_LDB(B0, 1, 0); PG8_SCHED; PG8_LDA(At, 1, 0); PG8_STAGE(PG8_SA(0, 1), a2 + hstep, voffA);
            PG8_WAIT_L(8); PG8_BAR; PG8_WAIT_L(0); PG8_MMA(0, 0, At, B0); PG8_BAR; PG8_SCHED;
            PG8_LDB(B1, 1, 1); PG8_STAGE(PG8_SB(1, 0), b3, voffB);
            PG8_BAR; PG8_WAIT_L(0); PG8_MMA(0, 1, At, B1); PG8_BAR;
            PG8_LDA(At, 1, 1); PG8_STAGE(PG8_SA(1, 0), a3, voffA);
            PG8_BAR; PG8_WAIT_L(0); PG8_MMA(1, 0, At, B0); PG8_BAR; PG8_SCHED;
            PG8_STAGE(PG8_SB(1, 1), b3 + hstep, voffB);
            PG8_WAIT_V(6); PG8_BAR; PG8_MMA(1, 1, At, B1); PG8_BAR;
            }
        }
        if constexpr (ALIGN_EPI) { if (wr == 0) PG8_BAR; }
        if constexpr (!Epi::AFTER_DRAIN) { E(acc, cur, wr, wc, fr, fq); S.done(cur); }
        if (!has_next) break;
#pragma unroll
        for (int a = 0; a < 2; ++a)
#pragma unroll
            for (int b = 0; b < 2; ++b)
#pragma unroll
                for (int m = 0; m < 4; ++m)
#pragma unroll
                    for (int n = 0; n < 2; ++n) acc[a][b][m][n] = (f32x4){0.f, 0.f, 0.f, 0.f};
        cur = nxt; cA = nA; cB = nB; ++ui;
        if constexpr (ALIGN_EPI) { if (wr == 1) PG8_BAR; }
    }
    PG8_WAIT_V(0);
    if constexpr (!ALIGN_EPI) { if (wr == 0) PG8_BAR; }
    PG8_BAR;
    if constexpr (Epi::AFTER_DRAIN) { E.fused(acc, cur, wr, wc, fr, fq, lds, wid, lane); S.done(cur); }
#undef PG8_SA
#undef PG8_SB
#undef PG8_STAGE
#undef PG8_LDA
#undef PG8_LDB
#undef PG8_MMA
#undef PG8_WAIT_V
#undef PG8_WAIT_L
#undef PG8_BAR
#undef PG8_SCHED
}
}

#ifndef PG8_SP2
#define PG8_SP2 true
#endif
#ifndef PG8_ALIGN
#define PG8_ALIGN true
#endif

namespace attn {
typedef unsigned short bf16;
constexpr int   D = 128, NW = 8, QBLK = 32, KVBLK = 64;
constexpr float SCALE = 0.088388347648318440f;
constexpr float THR = 8.f;
constexpr int SDEPTH = 2;
constexpr int LDQ = 2048, LDK = 512, LDO = 4096;
constexpr size_t SHM_V = KVBLK * D * 2, SHM_K = KVBLK * D * 2, SHM_ATTN = 2 * SHM_V + 2 * SHM_K + NW * 64 * 4;
using bf16x8 = __attribute__((ext_vector_type(8))) short;
using s16x4  = __attribute__((ext_vector_type(4))) short;
using f32x16 = __attribute__((ext_vector_type(16))) float;
using f32x8  = __attribute__((ext_vector_type(8))) float;
using u32x4  = __attribute__((ext_vector_type(4))) unsigned;
#define KSWZ(row, colB) ((row) * 256 + ((colB) ^ (((row) & 7) << 4)))
#define SBAR() __builtin_amdgcn_sched_barrier(0)
__device__ __forceinline__ int crow(int r, int hi) { return (r & 3) + 8 * (r >> 2) + 4 * hi; }
__device__ __forceinline__ unsigned cvtpk(float lo, float hi) {
  unsigned r; asm volatile("v_cvt_pk_bf16_f32 %0, %1, %2" : "=v"(r) : "v"(lo), "v"(hi)); return r;
}
__device__ __forceinline__ bf16 f2bf_rne(float f) { unsigned u = __builtin_bit_cast(unsigned, f); return (bf16)((u + 0x7fffu + ((u >> 16) & 1u)) >> 16); }
template <typename TIn> struct Stage;
template <> struct Stage<bf16>  { using T = bf16x8;
  __device__ static __forceinline__ T ld8(const bf16* p) { return *reinterpret_cast<const bf16x8*>(p); }
  __device__ static __forceinline__ bf16x8 tobf(T x) { return x; } };
template <> struct Stage<float> { using T = f32x8;
  __device__ static __forceinline__ T ld8(const float* p) { return *reinterpret_cast<const f32x8*>(p); }
  __device__ static __forceinline__ bf16x8 tobf(T x) {
    u32x4 w = {cvtpk(x[0], x[1]), cvtpk(x[2], x[3]), cvtpk(x[4], x[5]), cvtpk(x[6], x[7])}; return *reinterpret_cast<bf16x8*>(&w); } };

__device__ __forceinline__ void partialSM(f32x16& p0, f32x16& p1, float& m_reg, float& mn, float& alpha) {
  constexpr float C = SCALE * 1.4426950408889634f;
  float pmax = p0[0]; for (int r = 1; r < 16; ++r) pmax = fmaxf(pmax, p0[r]); for (int r = 0; r < 16; ++r) pmax = fmaxf(pmax, p1[r]);
  { auto rr = __builtin_amdgcn_permlane32_swap(__float_as_uint(pmax), __float_as_uint(pmax), false, false);
    pmax = fmaxf(__uint_as_float(rr[0]), __uint_as_float(rr[1])); }
  if (__builtin_expect(__all(pmax - m_reg <= THR / SCALE), 1)) { mn = m_reg; alpha = 1.f; }
  else { mn = fmaxf(m_reg, pmax); alpha = __builtin_amdgcn_exp2f((m_reg - mn) * C); m_reg = mn; }
  float mnC = -mn * C;
  for (int r = 0; r < 16; ++r) p0[r] = fmaf(p0[r], C, mnC); for (int r = 0; r < 16; ++r) p1[r] = fmaf(p1[r], C, mnC);
  for (int r = 0; r < 16; ++r) p0[r] = __builtin_amdgcn_exp2f(p0[r]);
}
__device__ __forceinline__ void finishSM(f32x16& p0, f32x16& p1, float alpha, float& l_reg, bf16x8& pa0, bf16x8& pa1, bf16x8& pa2, bf16x8& pa3) {
  for (int r = 0; r < 16; ++r) p1[r] = __builtin_amdgcn_exp2f(p1[r]);
  float ps = 0; for (int r = 0; r < 16; ++r) ps += p0[r]; for (int r = 0; r < 16; ++r) ps += p1[r];
  { auto rr = __builtin_amdgcn_permlane32_swap(__float_as_uint(ps), __float_as_uint(ps), false, false);
    ps = __uint_as_float(rr[0]) + __uint_as_float(rr[1]); }
  l_reg = l_reg * alpha + ps;
#define PK4(P, BASE, OUT) do { unsigned a0 = cvtpk(P[BASE + 0], P[BASE + 1]), a1 = cvtpk(P[BASE + 2], P[BASE + 3]);   \
    unsigned b0 = cvtpk(P[BASE + 4], P[BASE + 5]), b1 = cvtpk(P[BASE + 6], P[BASE + 7]);                              \
    auto r0 = __builtin_amdgcn_permlane32_swap(a0, b0, false, false); auto r1 = __builtin_amdgcn_permlane32_swap(a1, b1, false, false); \
    u32x4 w = {r0[0], r1[0], r0[1], r1[1]}; OUT = *reinterpret_cast<bf16x8*>(&w); } while (0)
  PK4(p0, 0, pa0); PK4(p0, 8, pa1); PK4(p1, 0, pa2); PK4(p1, 8, pa3);
#undef PK4
}
__device__ __forceinline__ void qkt(f32x16& p0, f32x16& p1, const bf16* Ks, const bf16x8* qr, int r32, int hi) {
  p0 = f32x16{}; p1 = f32x16{};
  for (int d0 = 0; d0 < 8; ++d0) { int cb = (d0 * 16 + hi * 8) * 2;
    bf16x8 b0 = *reinterpret_cast<const bf16x8*>((const char*)Ks + KSWZ(r32, cb));
    bf16x8 b1 = *reinterpret_cast<const bf16x8*>((const char*)Ks + KSWZ(32 + r32, cb));
    p0 = __builtin_amdgcn_mfma_f32_32x32x16_bf16(b0, qr[d0], p0, 0, 0, 0);
    p1 = __builtin_amdgcn_mfma_f32_32x32x16_bf16(b1, qr[d0], p1, 0, 0, 0); }
}
__device__ __forceinline__ int v_st(int k, int c) { const int kk = (k & ~0xC) | ((k & 4) << 1) | ((k & 8) >> 1); return ((kk >> 3) * 4 + (c >> 5)) * 512 + ((kk & 7) * 32 + (c & 31)) * 2; }
__device__ __forceinline__ int v_rd_base(int lane) { return ((lane & 3) << 3) | (((lane >> 2) & 3) << 6) | (((lane >> 4) & 1) << 5) | (((lane >> 5) & 1) << 8); }
constexpr int v_rd_off(int d0, int ks, int half) { return d0 * 512 + ks * 4096 + half * 2048; }
template <int OFF> __device__ __forceinline__ s16x4 tr_read(int vb) {
  s16x4 r; asm volatile("ds_read_b64_tr_b16 %0, %1 offset:%2" : "=&v"(r) : "v"(vb), "i"(OFF) : "memory"); return r;
}
template <int D0> __device__ __forceinline__ void pv_one(f32x16& od, int vb, bf16x8 pa0, bf16x8 pa1, bf16x8 pa2, bf16x8 pa3) {
  const s16x4 l0 = tr_read<v_rd_off(D0, 0, 0)>(vb), h0 = tr_read<v_rd_off(D0, 0, 1)>(vb), l1 = tr_read<v_rd_off(D0, 1, 0)>(vb), h1 = tr_read<v_rd_off(D0, 1, 1)>(vb);
  const s16x4 l2 = tr_read<v_rd_off(D0, 2, 0)>(vb), h2 = tr_read<v_rd_off(D0, 2, 1)>(vb), l3 = tr_read<v_rd_off(D0, 3, 0)>(vb), h3 = tr_read<v_rd_off(D0, 3, 1)>(vb);
  asm volatile("s_waitcnt lgkmcnt(0)" ::: "memory"); SBAR();
#define PK(L, H) (bf16x8){L[0], L[1], L[2], L[3], H[0], H[1], H[2], H[3]}
  od = __builtin_amdgcn_mfma_f32_32x32x16_bf16(pa0, PK(l0, h0), od, 0, 0, 0);
  od = __builtin_amdgcn_mfma_f32_32x32x16_bf16(pa1, PK(l1, h1), od, 0, 0, 0);
  od = __builtin_amdgcn_mfma_f32_32x32x16_bf16(pa2, PK(l2, h2), od, 0, 0, 0);
  od = __builtin_amdgcn_mfma_f32_32x32x16_bf16(pa3, PK(l3, h3), od, 0, 0, 0);
#undef PK
}
__device__ __forceinline__ void pv_d0(f32x16* o, int vb, bf16x8 pa0, bf16x8 pa1, bf16x8 pa2, bf16x8 pa3) {
  pv_one<0>(o[0], vb, pa0, pa1, pa2, pa3); pv_one<1>(o[1], vb, pa0, pa1, pa2, pa3); pv_one<2>(o[2], vb, pa0, pa1, pa2, pa3); pv_one<3>(o[3], vb, pa0, pa1, pa2, pa3);
}

template <typename TQ>
__device__ __forceinline__ void attn_dense_body(const TQ* __restrict__ Qb, const bf16* __restrict__ Kh, const bf16* __restrict__ Vh,
                                                bf16* __restrict__ Ob, int seq, char* lds, const int wave_) {
  using St = Stage<bf16>; using SQ = Stage<TQ>;
  const int lane = lane_id(), wid = wave_; __builtin_assume(lane >= 0 && lane < 64); __builtin_assume(wid >= 0 && wid < 8);
  const int tid = wid * 64 + lane, r32 = lane & 31, hi = lane >> 5;
  bf16* V_lds = (bf16*)lds; bf16* K_lds = (bf16*)(lds + 2 * SHM_V);
  float* ws = (float*)(lds + 2 * SHM_V + 2 * SHM_K) + wid * 64; float* li_l = ws; float* al_l = ws + 32;
  float m_reg = -1e30f, l_reg = 0; f32x16 o[4] = {}; bf16x8 qr[8];
  const TQ* Qw = Qb + (long)(wid * QBLK + r32) * LDQ + hi * 8;
#pragma unroll
  for (int d0 = 0; d0 < 8; ++d0) qr[d0] = SQ::tobf(SQ::ld8(Qw + d0 * 16));
  const int sr = tid >> 4, sc = (tid & 15) * 8, vst0 = v_st(sr, sc), vst1 = v_st(32 + sr, sc);
  const int vb0 = (int)(uintptr_t)V_lds + v_rd_base(lane);
  struct { typename St::T vs0, vs1, ks0, ks1; } sr_[SDEPTH];
#define SLOAD(i, k0) do { sr_[i].vs0 = St::ld8(&Vh[(long)((k0) + sr) * LDK + sc]); sr_[i].vs1 = St::ld8(&Vh[(long)((k0) + 32 + sr) * LDK + sc]); \
    sr_[i].ks0 = St::ld8(&Kh[(long)((k0) + sr) * LDK + sc]); sr_[i].ks1 = St::ld8(&Kh[(long)((k0) + 32 + sr) * LDK + sc]); } while (0)
#define SWRITE(b, i) do { *(bf16x8*)((char*)V_lds + (b) * SHM_V + vst0) = St::tobf(sr_[i].vs0);          \
    *(bf16x8*)((char*)V_lds + (b) * SHM_V + vst1) = St::tobf(sr_[i].vs1); int kc = sc * 2;               \
    *(bf16x8*)((char*)K_lds + (b) * SHM_K + KSWZ(sr, kc)) = St::tobf(sr_[i].ks0);                       \
    *(bf16x8*)((char*)K_lds + (b) * SHM_K + KSWZ(32 + sr, kc)) = St::tobf(sr_[i].ks1); } while (0)
#define SWAIT() do { if constexpr (SDEPTH == 2) asm volatile("s_waitcnt vmcnt(4)" ::: "memory"); else asm volatile("s_waitcnt vmcnt(0)" ::: "memory"); } while (0)
#define RESC(a) do { if (__any((a) < 1.f)) { if (hi == 0) al_l[r32] = (a); asm volatile("s_waitcnt lgkmcnt(0)" ::: "memory"); \
    for (int d = 0; d < 4; ++d) for (int r = 0; r < 16; ++r) o[d][r] *= al_l[crow(r, hi)]; } } while (0)
  f32x16 pA0, pA1, pB0, pB1; float mnA, mnB, alA, alB; bf16x8 pa0, pa1, pa2, pa3; const int NT = seq / KVBLK;
  constexpr int SE = 0, SO = SDEPTH - 1;
  SLOAD(SE, 0); asm volatile("s_waitcnt vmcnt(0)" ::: "memory"); SWRITE(0, SE); __syncthreads();
  qkt(pA0, pA1, K_lds, qr, r32, hi); partialSM(pA0, pA1, m_reg, mnA, alA);
  SLOAD(SO, KVBLK); if constexpr (SDEPTH == 2) { if (2 < NT) SLOAD(SE, 2 * KVBLK); }
  SWAIT(); SWRITE(1, SO); __syncthreads();
  for (int j = 1; j + 1 < NT; j += 2) {
    SBAR(); qkt(pB0, pB1, (bf16*)((char*)K_lds + SHM_K), qr, r32, hi);
    finishSM(pA0, pA1, alA, l_reg, pa0, pa1, pa2, pa3); SBAR();
    SLOAD(SO, (j + SDEPTH) * KVBLK); SBAR();
    pv_d0(o, vb0, pa0, pa1, pa2, pa3); partialSM(pB0, pB1, m_reg, mnB, alB);
    __syncthreads(); SWAIT(); SWRITE(0, SE);
    RESC(alB); __syncthreads();
    SBAR(); qkt(pA0, pA1, K_lds, qr, r32, hi);
    finishSM(pB0, pB1, alB, l_reg, pa0, pa1, pa2, pa3); SBAR();
    if (SDEPTH == 1 || j + 3 < NT) SLOAD(SE, (j + 1 + SDEPTH) * KVBLK); SBAR();
    pv_d0(o, vb0 + (int)SHM_V, pa0, pa1, pa2, pa3); partialSM(pA0, pA1, m_reg, mnA, alA);
    __syncthreads(); SWAIT(); SWRITE(1, SO);
    RESC(alA); __syncthreads();
  }
  SBAR(); qkt(pB0, pB1, (bf16*)((char*)K_lds + SHM_K), qr, r32, hi);
  finishSM(pA0, pA1, alA, l_reg, pa0, pa1, pa2, pa3); SBAR();
  pv_d0(o, vb0, pa0, pa1, pa2, pa3); partialSM(pB0, pB1, m_reg, mnB, alB);
  __syncthreads(); RESC(alB);
  finishSM(pB0, pB1, alB, l_reg, pa0, pa1, pa2, pa3); SBAR();
  pv_d0(o, vb0 + (int)SHM_V, pa0, pa1, pa2, pa3);
  if (hi == 0) li_l[r32] = l_reg; asm volatile("s_waitcnt lgkmcnt(0)" ::: "memory");
  float rli[16];
#pragma unroll
  for (int r = 0; r < 16; ++r) rli[r] = __builtin_amdgcn_rcpf(li_l[crow(r, hi)]);
  bf16* Ow = Ob + (long)(wid * QBLK) * LDO;
#pragma unroll
  for (int r = 0; r < 16; ++r) { int orow = crow(r, hi);
    for (int d0 = 0; d0 < 4; ++d0) Ow[(long)orow * LDO + d0 * 32 + r32] = f2bf_rne(o[d0][r] * rli[r]); }
#undef SLOAD
#undef SWRITE
#undef SWAIT
#undef RESC
}
}

constexpr int NWAVES = 8;
#ifndef MK_ONE_LAUNCH
#define MK_ONE_LAUNCH 1
#endif

constexpr int DM = 4096, SEQ = 8192, CTXN = 256, MROWS = SEQ + CTXN;
constexpr int AW = 2048, BWID = 2048, HD = 128, NHQ = 16, NKVH = 4, KVW = 512;
constexpr int INC = 7168, DFF = 11008, UPC = 2 * DFF;
constexpr int ZQ0 = 4096, ZK0 = 6144, ZV0 = 6656;
constexpr float EPSN = 1e-6f;
constexpr int NMODV = 32768;

constexpr size_t MiB = 1u << 20;
constexpr size_t WS_CTL = 0, CTL_ZERO_BYTES = 1 * MiB;
constexpr size_t WS_MODS = 1 * MiB;
constexpr size_t WS_ROPE = 1 * MiB + 256 * 1024;
constexpr size_t WS_LNST = 2 * MiB;
constexpr size_t WS_PART = 4 * MiB;
constexpr size_t WS_WIN = 16 * MiB, WS_WOUT = 72 * MiB, WS_WUP = 104 * MiB, WS_WDN = 276 * MiB;
constexpr size_t WS_H = 362 * MiB;
constexpr size_t WS_Z = 428 * MiB;
constexpr size_t WS_Q = 544 * MiB, WS_K = 576 * MiB, WS_V = 585 * MiB;
constexpr size_t WS_MIX = 594 * MiB;
constexpr size_t WS_O = 658 * MiB;
constexpr size_t WS_UP = 786 * MiB;
constexpr size_t WS_G = 1130 * MiB;
constexpr size_t WS_END = 1302 * MiB;
constexpr int CW_BAR = 4096;

constexpr int RING_OFF = 0, RING_BYTES = 131072;
constexpr int LDSCTL_OFF = RING_BYTES, MISC_OFF = LDSCTL_OFF + 320;
constexpr int LDS_BYTES = 147456;

#define GAS __attribute__((address_space(1)))
#define LAS __attribute__((address_space(3)))
typedef unsigned short bf16;
typedef unsigned v4u __attribute__((ext_vector_type(4)));
typedef float f32x4 __attribute__((ext_vector_type(4)));
typedef short bf16x8 __attribute__((ext_vector_type(8)));
typedef GAS unsigned gu32;
typedef GAS unsigned long long gu64;
#define RLX_AGENT __ATOMIC_RELAXED, __HIP_MEMORY_SCOPE_AGENT
#define LDS_WAIT() asm volatile("s_waitcnt lgkmcnt(0)" ::: "memory")
#define VM_WAIT() asm volatile("s_waitcnt vmcnt(0)" ::: "memory")
__device__ __forceinline__ unsigned long long rt() { return __builtin_amdgcn_s_memrealtime(); }
__device__ __forceinline__ unsigned f2bf(float f) { unsigned u = __builtin_bit_cast(unsigned, f); return (u + 0x7fffu + ((u >> 16) & 1u)) >> 16; }
__device__ __forceinline__ unsigned pk2(float lo, float hi) { return f2bf(lo) | (f2bf(hi) << 16); }

#define XB_TMO      128
#define XB_XCNT(j)  (256  + 64 * (j))
#define XB_XSUB(j)  (1280 + 64 * (j))
#define XB_XGEN(j)  (2304 + 64 * (j))
#define XB_TOP      3328
#define XB_TOPGEN   3392
#define XCD_BAR_WORDS 3456
#define XB_SPIN_CAP (1u << 18)

__device__ __forceinline__ unsigned xb_ld(unsigned* p)              { return __hip_atomic_load(p, __ATOMIC_RELAXED, __HIP_MEMORY_SCOPE_AGENT); }
__device__ __forceinline__ unsigned xb_add(unsigned* p, unsigned v) { return __hip_atomic_fetch_add(p, v, __ATOMIC_RELAXED, __HIP_MEMORY_SCOPE_AGENT); }
__device__ __forceinline__ unsigned xb_xcc_id() { return (unsigned)__builtin_amdgcn_s_getreg((3 << 11) | 20) & 0xFu; }
#define XB_SPIN(cond, bar) do { unsigned _sp = 0; while (cond) { __builtin_amdgcn_s_sleep(1); \
    if ((++_sp & 255u) == 0u) { if (xb_ld(&(bar)[XB_TMO])) break; if (_sp > XB_SPIN_CAP) { atomicAdd(&(bar)[XB_TMO], 1u); break; } } } } while (0)

struct XcdBarrier {
    unsigned* bar; unsigned x;
    volatile LAS unsigned* st;
};

__device__ __forceinline__ XcdBarrier xcd_barrier_post(unsigned* bar, volatile LAS unsigned* st) {
    XcdBarrier b; b.bar = bar; b.x = xb_xcc_id(); b.st = st;
    if (threadIdx.x == 0) (void)xb_add(&bar[XB_XCNT(b.x)], 1u);
    return b;
}
__device__ __forceinline__ void xcd_barrier_complete(unsigned* bar, unsigned x, unsigned& nloc, unsigned& nx) {
    const unsigned G = gridDim.x * gridDim.y * gridDim.z;
    unsigned sum, cnt, mine, sp = 0u;
    for (;;) {
        sum = 0u; cnt = 0u; mine = 0u;
#pragma unroll
        for (unsigned j = 0; j < 16; ++j) { const unsigned c = xb_ld(&bar[XB_XCNT(j)]); sum += c; cnt += (c > 0u) ? 1u : 0u; mine = (j == x) ? c : mine; }
        if (sum == G) break;
        __builtin_amdgcn_s_sleep(1);
        if ((++sp & 255u) == 0u) { if (xb_ld(&bar[XB_TMO])) break; if (sp > XB_SPIN_CAP) { atomicAdd(&bar[XB_TMO], 1u); break; } }
    }
    nloc = mine > 0u ? mine : 1u; nx = cnt > 0u ? cnt : 1u;
}

__device__ __forceinline__ void xcd_barrier(const XcdBarrier& b) {
    asm volatile("s_waitcnt vmcnt(0)" ::: "memory");
    __syncthreads();
    if (threadIdx.x == 0) {
        unsigned* bar = b.bar;
        __builtin_amdgcn_s_waitcnt(0);
        unsigned nloc = b.st[0], nx = b.st[1];
        if (nloc == 0u) { xcd_barrier_complete(bar, b.x, nloc, nx); b.st[0] = nloc; b.st[1] = nx; }
        const unsigned old = xb_add(&bar[XB_XSUB(b.x)], 1u);
        const unsigned gen = old / nloc;
        if (old + 1u == (gen + 1u) * nloc) {
            __builtin_amdgcn_fence(__ATOMIC_RELEASE, "agent");
            asm volatile("s_waitcnt vmcnt(0)" ::: "memory");
            const unsigned og = xb_add(&bar[XB_TOP], 1u);
            const unsigned tg = og / nx;
            if (og + 1u == (tg + 1u) * nx) xb_add(&bar[XB_TOPGEN], 1u);
            else XB_SPIN(xb_ld(&bar[XB_TOPGEN]) == tg, bar);
            __builtin_amdgcn_fence(__ATOMIC_ACQUIRE, "agent");
            xb_add(&bar[XB_XGEN(b.x)], 1u);
            asm volatile("s_waitcnt vmcnt(0)" ::: "memory");
        } else {
            XB_SPIN(xb_ld(&bar[XB_XGEN(b.x)]) == gen, bar);
            __builtin_amdgcn_fence(__ATOMIC_ACQUIRE, "agent");
            asm volatile("s_waitcnt vmcnt(0)" ::: "memory");
        }
    }
    __syncthreads();
}

typedef float f32x2v __attribute__((ext_vector_type(2)));
typedef unsigned u32x2v __attribute__((ext_vector_type(2)));
typedef float f32x16 __attribute__((ext_vector_type(16)));
__device__ __forceinline__ float wave_sum(float v) {
#pragma unroll
    for (int o = 1; o < 64; o <<= 1) v += __shfl_xor(v, o);
    return v;
}
__device__ __forceinline__ float bflo(unsigned w) { return __uint_as_float(w << 16); }
__device__ __forceinline__ float bfhi(unsigned w) { return __uint_as_float(w & 0xffff0000u); }
__device__ __forceinline__ float bf2f(bf16 b) { return __uint_as_float(((unsigned)b) << 16); }
__device__ __forceinline__ float gelu_erf(float v) { return 0.5f * v * (1.0f + erff(v * 0.70710678118654752f)); }
__device__ __forceinline__ float silu_f(float v) { return v / (1.0f + __expf(-v)); }
__device__ __forceinline__ float dot4(f32x4 a) { return (a.x * a.x + a.y * a.y) + (a.z * a.z + a.w * a.w); }

__device__ __forceinline__ void ph_gemv(const float* c, const float* cx, const float* w_ada, float* part, LAS float* sl, int tid, int bid, int G) {
    for (int k = tid; k < DM; k += NWAVES * 64) { const float a = c[k]; sl[k] = a / (1.0f + expf(-a)); const float b = cx[k]; sl[DM + k] = b / (1.0f + expf(-b)); }
    __syncthreads();
    const int half = tid >> 8, tx = tid & 255;
    for (int it = bid; it < 768; it += G) {
        const int jt = it % 24, ks = it / 24;
        const int j0 = jt * 1024 + tx * 4, kbase = ks * 128 + half * 64;
        const f32x4* wp = (const f32x4*)(w_ada + (size_t)kbase * (6 * DM) + j0);
        f32x4 ac = (f32x4){0.f, 0.f, 0.f, 0.f}, ax = (f32x4){0.f, 0.f, 0.f, 0.f};
#pragma unroll 8
        for (int i = 0; i < 64; ++i) { const f32x4 w = wp[(size_t)i * (6 * DM / 4)]; const float sc = sl[kbase + i], sx = sl[DM + kbase + i]; ac += w * sc; ax += w * sx; }
        float* po = part + (size_t)(ks * 2 + half) * NMODV;
        *(f32x4*)(po + j0) = ac;
        if (jt < 8) *(f32x4*)(po + 6 * DM + j0) = ax;
    }
    __syncthreads();
}
__device__ __forceinline__ void ph_rope_table(float* rope, int tid, int bid) {
    const int gid = bid * (NWAVES * 64) + tid;
    if (gid < 4096) { const int pos = gid >> 5, i = gid & 31; const float fr = powf(10000.0f, -(float)i / 32.0f); const float ang = (float)pos * fr; rope[gid] = cosf(ang); rope[4096 + gid] = sinf(ang); }
}
__device__ __forceinline__ void transpose_item(const float* W, int N, int k0, int n_src0, bf16* WT, int K, int n_dst0, LAS float* scr, int lane) {
#pragma unroll 8
    for (int i = 0; i < 32; ++i) { const int kk = 2 * i + (lane >> 5); scr[kk * 33 + (lane & 31)] = W[(size_t)(k0 + kk) * N + n_src0 + (lane & 31)]; }
    LDS_WAIT(); asm volatile("" ::: "memory");
    const int c = lane & 7;
#pragma unroll
    for (int j = 0; j < 4; ++j) { const int n = (lane >> 3) + 8 * j; const LAS float* s = scr + (8 * c) * 33 + n;
        v4u o; o.x = pk2(s[0 * 33], s[1 * 33]); o.y = pk2(s[2 * 33], s[3 * 33]); o.z = pk2(s[4 * 33], s[5 * 33]); o.w = pk2(s[6 * 33], s[7 * 33]);
        *(GAS v4u*)(WT + (size_t)(n_dst0 + n) * K + k0 + 8 * c) = o; }
    LDS_WAIT(); asm volatile("" ::: "memory");
}
__device__ __forceinline__ void ph_convert(const float* w_in, const float* w_out, const float* w_up, const float* w_dn, bf16* win_t, bf16* wout_t, bf16* wup_t, bf16* wdn_t,
                                           LAS float* scr, int gw, int NGW, int lane) {
    constexpr int I_IN = (DM / 64) * (INC / 32), I_OUT = (DM / 64) * (DM / 32), I_UP = (DM / 64) * (UPC / 32), I_DN = (DFF / 64) * (DM / 32);
    constexpr int NITEMS = I_IN + I_OUT + I_UP + I_DN;
    for (int it = gw; it < NITEMS; it += NGW) {
        int r = it;
        if (r < I_IN) { const int nblk = INC / 32, kb = r / nblk, nb = r % nblk; transpose_item(w_in, INC, 64 * kb, 32 * nb, win_t, DM, 32 * nb, scr, lane); continue; } r -= I_IN;
        if (r < I_OUT) { const int nblk = DM / 32, kb = r / nblk, nb = r % nblk; transpose_item(w_out, DM, 64 * kb, 32 * nb, wout_t, DM, 32 * nb, scr, lane); continue; } r -= I_OUT;
        if (r < I_UP) { const int nblk = UPC / 32, kb = r / nblk, nb = r % nblk; const int T = nb >> 3, w = nb & 7;
            const int src = (w < 4) ? (T * 128 + w * 32) : (DFF + T * 128 + (w - 4) * 32);
            transpose_item(w_up, UPC, 64 * kb, src, wup_t, DM, 32 * nb, scr, lane); continue; } r -= I_UP;
        { const int nblk = DM / 32, kb = r / nblk, nb = r % nblk; transpose_item(w_dn, DM, 64 * kb, 32 * nb, wdn_t, DFF, 32 * nb, scr, lane); }
    }
}
__device__ __forceinline__ void ph_mods_reduce(const float* part, const float* b_ada, float* mods, LAS float* red, int tid, int bid, int G) {
    for (int ob = bid; ob < NMODV / 128; ob += G) {
        const int o = tid & 127, pr = tid >> 7; float s = 0.f;
#pragma unroll 4
        for (int i = 0; i < 16; ++i) s += part[(size_t)(pr * 16 + i) * NMODV + ob * 128 + o];
        red[pr * 128 + o] = s; __syncthreads();
        if (tid < 128) { const int j = ob * 128 + tid; float t = (red[tid] + red[128 + tid]) + (red[256 + tid] + red[384 + tid]); t += b_ada[j < 6 * DM ? j : j - 6 * DM]; mods[j] = t; }
        __syncthreads();
    }
}
__device__ __forceinline__ void ph_prenorm(const float* x, const float* ctx, const float* g, const float* mods, bf16* H, int gw, int NGW, int lane) {
    for (int m = gw; m < MROWS; m += NGW) {
        asm volatile("" ::: "memory");
        const bool lat = m < SEQ;
        const GAS f32x4* src = (const GAS f32x4*)(lat ? x + (size_t)m * DM : ctx + (size_t)(m - SEQ) * DM) + lane;
        const f32x4* sh = (const f32x4*)(mods + (lat ? 0 : 6 * DM)) + lane; const f32x4* sc = (const f32x4*)(mods + (lat ? DM : 7 * DM)) + lane; const f32x4* gg = (const f32x4*)g + lane;
        f32x4 v[16]; float ss = 0.f;
#pragma unroll
        for (int j = 0; j < 16; ++j) { v[j] = src[64 * j]; ss += dot4(v[j]); }
        const float rstd = rsqrtf(wave_sum(ss) * (1.0f / DM) + EPSN);
        GAS u32x2v* o8 = (GAS u32x2v*)(H + (size_t)m * DM) + lane;
#pragma unroll
        for (int j = 0; j < 16; ++j) { const f32x4 a = v[j] * rstd * gg[64 * j] * (sc[64 * j] + 1.0f) + sh[64 * j]; u32x2v w; w.x = pk2(a.x, a.y); w.y = pk2(a.z, a.w); o8[64 * j] = w; }
    }
}
__device__ __forceinline__ void ph_qk(const bf16* Z, const float* g_q, const float* g_k, const float* rope, bf16* Qn, bf16* Kn, bf16* Vn, float* lnst, int gw, int NGW, int lane) {
    const int fi = 2 * (lane & 15);
    const f32x2v gq = *(const f32x2v*)(g_q + 2 * lane), gk = *(const f32x2v*)(g_k + 2 * lane);
    for (int m = gw; m < MROWS; m += NGW) {
        const bf16* zr = Z + (size_t)m * INC; const bool lat = m < SEQ;
        const int pos = (lane < 32) ? (m >> 6) : (m & 63);
        f32x2v cs = (f32x2v){1.f, 1.f}, sn = (f32x2v){0.f, 0.f};
        if (lat) { cs = *(const f32x2v*)(rope + pos * 32 + fi); sn = *(const f32x2v*)(rope + 4096 + pos * 32 + fi); }
        const float sgn = (lane & 16) ? 1.0f : -1.0f;
        if (lat) {
#pragma unroll 4
            for (int h = 0; h < NHQ; ++h) {
                const unsigned w = *(const unsigned*)(zr + ZQ0 + h * HD + 2 * lane); float a = bflo(w), b = bfhi(w);
                const float rstd = rsqrtf(wave_sum(a * a + b * b) * (1.0f / HD) + EPSN); a *= rstd * gq.x; b *= rstd * gq.y;
                const float oa = __shfl_xor(a, 16), ob = __shfl_xor(b, 16);
                *(unsigned*)(Qn + (size_t)m * BWID + h * HD + 2 * lane) = pk2(a * cs.x + sgn * oa * sn.x, b * cs.y + sgn * ob * sn.y);
            }
        }
#pragma unroll
        for (int h = 0; h < NKVH; ++h) {
            const unsigned w = *(const unsigned*)(zr + ZK0 + h * HD + 2 * lane); float a = bflo(w), b = bfhi(w);
            const float rstd = rsqrtf(wave_sum(a * a + b * b) * (1.0f / HD) + EPSN); a *= rstd * gk.x; b *= rstd * gk.y;
            const float oa = __shfl_xor(a, 16), ob = __shfl_xor(b, 16);
            *(unsigned*)(Kn + (size_t)m * KVW + h * HD + 2 * lane) = pk2(a * cs.x + sgn * oa * sn.x, b * cs.y + sgn * ob * sn.y);
        }
        *(v4u*)(Vn + (size_t)m * KVW + 8 * lane) = *(const v4u*)(zr + ZV0 + 8 * lane);
        if (lat) {
            float gv[32]; float s = 0.f;
#pragma unroll
            for (int j = 0; j < 4; ++j) { const v4u w = *(const v4u*)(zr + AW + 8 * lane + 512 * j);
                gv[8 * j + 0] = gelu_erf(bflo(w.x)); gv[8 * j + 1] = gelu_erf(bfhi(w.x)); gv[8 * j + 2] = gelu_erf(bflo(w.y)); gv[8 * j + 3] = gelu_erf(bfhi(w.y));
                gv[8 * j + 4] = gelu_erf(bflo(w.z)); gv[8 * j + 5] = gelu_erf(bfhi(w.z)); gv[8 * j + 6] = gelu_erf(bflo(w.w)); gv[8 * j + 7] = gelu_erf(bfhi(w.w)); }
#pragma unroll
            for (int i = 0; i < 32; ++i) s += gv[i];
            const float mean = wave_sum(s) * (1.0f / AW); float q = 0.f;
#pragma unroll
            for (int i = 0; i < 32; ++i) { const float d = gv[i] - mean; q += d * d; }
            const float rstd = rsqrtf(wave_sum(q) * (1.0f / AW) + EPSN);
            if (lane == 0) *(f32x2v*)(lnst + 2 * m) = (f32x2v){mean, rstd};
        }
    }
}
constexpr int CM_LD = 136;
__device__ __forceinline__ void ph_chunk_mlp(const bf16* Z, const float* lnst, const float* ln_g, const float* ln_b, const float* w_s, const float* b_s, bf16* MIX,
                                             LAS unsigned char* lds, int tid, int bid, int G) {
    LAS bf16* As = (LAS bf16*)lds; LAS bf16* Bs = As + 128 * CM_LD;
    const int lane = tid & 63, wid = tid >> 6, r32 = lane & 31, hi = lane >> 5, pb = wid & 3, ch = wid >> 2;
    for (int u = bid; u < 64 * 16; u += G) {
        const int n = u >> 4, g = u & 15;
#pragma unroll
        for (int i = 0; i < 8; ++i) { const int e = (i * 512 + tid) * 4, p = e >> 7, q = e & 127; const f32x4 w = *(const f32x4*)(w_s + (size_t)g * 16384 + e);
            u32x2v o; o.x = pk2(w.x, w.y); o.y = pk2(w.z, w.w); *(LAS u32x2v*)(As + p * CM_LD + q) = o; }
#pragma unroll
        for (int i = 0; i < 4; ++i) { const int e = i * 512 + tid, q = e >> 4, c8 = (e & 15) * 8; const int row = n * 128 + q;
            const v4u w = *(const v4u*)(Z + (size_t)row * INC + AW + g * 128 + c8); const f32x2v st = *(const f32x2v*)(lnst + 2 * row);
            const f32x4 g0 = *(const f32x4*)(ln_g + g * 128 + c8), g1 = *(const f32x4*)(ln_g + g * 128 + c8 + 4), b0 = *(const f32x4*)(ln_b + g * 128 + c8), b1 = *(const f32x4*)(ln_b + g * 128 + c8 + 4);
            float v[8] = {bflo(w.x), bfhi(w.x), bflo(w.y), bfhi(w.y), bflo(w.z), bfhi(w.z), bflo(w.w), bfhi(w.w)};
            const float gm[8] = {g0.x, g0.y, g0.z, g0.w, g1.x, g1.y, g1.z, g1.w}, bt[8] = {b0.x, b0.y, b0.z, b0.w, b1.x, b1.y, b1.z, b1.w};
#pragma unroll
            for (int k = 0; k < 8; ++k) { const float y = (gelu_erf(v[k]) - st.x) * st.y * gm[k] + bt[k]; Bs[(c8 + k) * CM_LD + q] = (bf16)f2bf(y); } }
        __syncthreads();
        f32x16 acc0 = {}, acc1 = {};
#pragma unroll
        for (int ks = 0; ks < 8; ++ks) {
            const bf16x8 a = *(const LAS bf16x8*)(As + (32 * pb + r32) * CM_LD + ks * 16 + hi * 8);
            const bf16x8 b0 = *(const LAS bf16x8*)(Bs + (64 * ch + r32) * CM_LD + ks * 16 + hi * 8);
            const bf16x8 b1 = *(const LAS bf16x8*)(Bs + (64 * ch + 32 + r32) * CM_LD + ks * 16 + hi * 8);
            acc0 = __builtin_amdgcn_mfma_f32_32x32x16_bf16(a, b0, acc0, 0, 0, 0);
            acc1 = __builtin_amdgcn_mfma_f32_32x32x16_bf16(a, b1, acc1, 0, 0, 0);
        }
#pragma unroll
        for (int r = 0; r < 16; ++r) { const int p = 32 * pb + (r & 3) + 8 * (r >> 2) + 4 * hi; const int row = n * 128 + p; const float bs = b_s[g * 128 + p];
            const int c0 = g * 128 + 64 * ch + r32;
            const float u0 = gelu_erf(bf2f(Z[(size_t)row * INC + c0])), u1 = gelu_erf(bf2f(Z[(size_t)row * INC + c0 + 32]));
            MIX[(size_t)row * DM + c0] = (bf16)f2bf(u0 * (acc0[r] + bs)); MIX[(size_t)row * DM + c0 + 32] = (bf16)f2bf(u1 * (acc1[r] + bs)); }
        __syncthreads();
    }
}
__device__ __forceinline__ void ph_mixnorm(bf16* MIX, const float* g_a, const float* g_b, int gw, int NGW, int lane) {
    for (int m = gw; m < SEQ; m += NGW) {
        asm volatile("" ::: "memory");
        GAS v4u* rp = (GAS v4u*)(MIX + (size_t)m * DM) + lane; v4u w[8]; float sa = 0.f, sb = 0.f;
#pragma unroll
        for (int j = 0; j < 8; ++j) { w[j] = rp[64 * j]; const float t = (bflo(w[j].x) * bflo(w[j].x) + bfhi(w[j].x) * bfhi(w[j].x)) + (bflo(w[j].y) * bflo(w[j].y) + bfhi(w[j].y) * bfhi(w[j].y))
                + (bflo(w[j].z) * bflo(w[j].z) + bfhi(w[j].z) * bfhi(w[j].z)) + (bflo(w[j].w) * bflo(w[j].w) + bfhi(w[j].w) * bfhi(w[j].w)); if (j < 4) sa += t; else sb += t; }
        const float ra = rsqrtf(wave_sum(sa) * (1.0f / AW) + EPSN), rb = rsqrtf(wave_sum(sb) * (1.0f / BWID) + EPSN);
#pragma unroll
        for (int j = 0; j < 8; ++j) { const float r = j < 4 ? ra : rb; const float* gp = (j < 4 ? g_a + 512 * j : g_b + 512 * (j - 4)) + 8 * lane;
            const f32x4 g0 = *(const f32x4*)gp, g1 = *(const f32x4*)(gp + 4); v4u o;
            o.x = pk2(bflo(w[j].x) * r * g0.x, bfhi(w[j].x) * r * g0.y); o.y = pk2(bflo(w[j].y) * r * g0.z, bfhi(w[j].y) * r * g0.w);
            o.z = pk2(bflo(w[j].z) * r * g1.x, bfhi(w[j].z) * r * g1.y); o.w = pk2(bflo(w[j].w) * r * g1.z, bfhi(w[j].w) * r * g1.w); rp[64 * j] = o; }
    }
}
__device__ __forceinline__ void ph_postmix(const float* O, const float* x, const float* g_post, const float* g_pre2, const float* mods, float* out, bf16* H, LAS float* cl, int tid, int gw, int NGW, int lane) {
    for (int k = tid; k < DM; k += NWAVES * 64) { cl[k] = mods[2 * DM + k] * g_post[k]; cl[DM + k] = g_pre2[k] * (1.0f + mods[4 * DM + k]); cl[2 * DM + k] = mods[3 * DM + k]; }
    __syncthreads();
    const LAS f32x4* cA = (const LAS f32x4*)cl + lane; const LAS f32x4* cB = (const LAS f32x4*)(cl + DM) + lane; const LAS f32x4* cC = (const LAS f32x4*)(cl + 2 * DM) + lane;
    for (int m = gw; m < SEQ; m += NGW) {
        asm volatile("" ::: "memory");
        const GAS f32x4* op = (const GAS f32x4*)(O + (size_t)m * DM) + lane; const GAS f32x4* xp = (const GAS f32x4*)(x + (size_t)m * DM) + lane;
        f32x4 v[16]; float ss = 0.f;
#pragma unroll
        for (int j = 0; j < 16; ++j) { v[j] = op[64 * j]; ss += dot4(v[j]); }
        const float rstd = rsqrtf(wave_sum(ss) * (1.0f / DM) + EPSN); float s2 = 0.f;
        asm volatile("" ::: "memory");
        GAS f32x4* outp = (GAS f32x4*)(out + (size_t)m * DM) + lane;
#pragma unroll
        for (int j = 0; j < 16; ++j) { v[j] = xp[64 * j] + cA[64 * j] * (v[j] * rstd); s2 += dot4(v[j]); outp[64 * j] = v[j]; }
        const float rstd2 = rsqrtf(wave_sum(s2) * (1.0f / DM) + EPSN);
        asm volatile("" ::: "memory");
        GAS u32x2v* o8 = (GAS u32x2v*)(H + (size_t)m * DM) + lane;
#pragma unroll
        for (int j = 0; j < 16; ++j) { const f32x4 a = v[j] * rstd2 * cB[64 * j] + cC[64 * j]; u32x2v w; w.x = pk2(a.x, a.y); w.y = pk2(a.z, a.w); o8[64 * j] = w; }
    }
    __syncthreads();
}
__device__ __forceinline__ void ph_conv(const bf16* UP, const float* cw, const float* cb, bf16* Gb, int gtid, int NT) {
    constexpr int RB = 16, NCG = (DFF / 128) * 16, NIT = (SEQ / RB) * NCG;
    for (int it = gtid; it < NIT; it += NT) {
        const int cg = it % NCG, rr = it / NCG, T = cg >> 4, c8 = (cg & 15) * 8, r0 = rr * RB;
        const int f0 = T * 128 + c8;
        const size_t colg = (size_t)T * 256 + c8, colu = colg + 128;
        float wg[3][8], wu[3][8], bg[8], bu[8];
#pragma unroll
        for (int j = 0; j < 3; ++j) { const f32x4 a0 = *(const f32x4*)(cw + (size_t)j * UPC + f0), a1 = *(const f32x4*)(cw + (size_t)j * UPC + f0 + 4), b0 = *(const f32x4*)(cw + (size_t)j * UPC + DFF + f0), b1 = *(const f32x4*)(cw + (size_t)j * UPC + DFF + f0 + 4);
            wg[j][0] = a0.x; wg[j][1] = a0.y; wg[j][2] = a0.z; wg[j][3] = a0.w; wg[j][4] = a1.x; wg[j][5] = a1.y; wg[j][6] = a1.z; wg[j][7] = a1.w;
            wu[j][0] = b0.x; wu[j][1] = b0.y; wu[j][2] = b0.z; wu[j][3] = b0.w; wu[j][4] = b1.x; wu[j][5] = b1.y; wu[j][6] = b1.z; wu[j][7] = b1.w; }
        { const f32x4 a0 = *(const f32x4*)(cb + f0), a1 = *(const f32x4*)(cb + f0 + 4), b0 = *(const f32x4*)(cb + DFF + f0), b1 = *(const f32x4*)(cb + DFF + f0 + 4);
            bg[0] = a0.x; bg[1] = a0.y; bg[2] = a0.z; bg[3] = a0.w; bg[4] = a1.x; bg[5] = a1.y; bg[6] = a1.z; bg[7] = a1.w;
            bu[0] = b0.x; bu[1] = b0.y; bu[2] = b0.z; bu[3] = b0.w; bu[4] = b1.x; bu[5] = b1.y; bu[6] = b1.z; bu[7] = b1.w; }
        v4u pg, pu, cg4, cu4, ng, nu; const v4u zero = (v4u){0u, 0u, 0u, 0u};
        pg = r0 > 0 ? *(const v4u*)(UP + (size_t)(r0 - 1) * UPC + colg) : zero; pu = r0 > 0 ? *(const v4u*)(UP + (size_t)(r0 - 1) * UPC + colu) : zero;
        cg4 = *(const v4u*)(UP + (size_t)r0 * UPC + colg); cu4 = *(const v4u*)(UP + (size_t)r0 * UPC + colu);
#pragma unroll 4
        for (int r = r0; r < r0 + RB; ++r) {
            ng = (r + 1 < SEQ) ? *(const v4u*)(UP + (size_t)(r + 1) * UPC + colg) : zero; nu = (r + 1 < SEQ) ? *(const v4u*)(UP + (size_t)(r + 1) * UPC + colu) : zero;
            float o[8];
#define CV(k, W, HL) { const float ag = wg[0][k] * HL(pg.W) + wg[1][k] * HL(cg4.W) + wg[2][k] * HL(ng.W) + bg[k]; const float au = wu[0][k] * HL(pu.W) + wu[1][k] * HL(cu4.W) + wu[2][k] * HL(nu.W) + bu[k]; o[k] = silu_f(ag) * au; }
            CV(0, x, bflo) CV(1, x, bfhi) CV(2, y, bflo) CV(3, y, bfhi) CV(4, z, bflo) CV(5, z, bfhi) CV(6, w, bflo) CV(7, w, bfhi)
#undef CV
            v4u ov; ov.x = pk2(o[0], o[1]); ov.y = pk2(o[2], o[3]); ov.z = pk2(o[4], o[5]); ov.w = pk2(o[6], o[7]);
            *(v4u*)(Gb + (size_t)r * DFF + f0) = ov;
            pg = cg4; pu = cu4; cg4 = ng; cu4 = nu;
        }
    }
}
__device__ __forceinline__ void ph_final(const float* Fm, const float* g_post, const float* mods, float* out, int gw, int NGW, int lane) {
    const f32x4* gtf = (const f32x4*)(mods + 5 * DM) + lane; const f32x4* gp = (const f32x4*)g_post + lane;
    for (int m = gw; m < SEQ; m += NGW) {
        asm volatile("" ::: "memory");
        const GAS f32x4* fp = (const GAS f32x4*)(Fm + (size_t)m * DM) + lane; GAS f32x4* outp = (GAS f32x4*)(out + (size_t)m * DM) + lane;
        f32x4 v[16]; float ss = 0.f;
#pragma unroll
        for (int j = 0; j < 16; ++j) { v[j] = fp[64 * j]; ss += dot4(v[j]); }
        const float rstd = rsqrtf(wave_sum(ss) * (1.0f / DM) + EPSN);
#pragma unroll
        for (int j = 0; j < 16; ++j) outp[64 * j] = outp[64 * j] + gtf[64 * j] * (v[j] * rstd * gp[64 * j]);
    }
}

constexpr int NPHASE = 14;
struct Args { const float* in[24]; float* out; unsigned char* ws; int ph_lo, ph_hi; };
__global__ void __launch_bounds__(NWAVES * 64, 2) skel_fwd(Args args) {
    extern __shared__ __attribute__((aligned(16))) unsigned char lds[];
    LAS unsigned char* ldsb = (LAS unsigned char*)lds;
    volatile LAS unsigned* MISC = (volatile LAS unsigned*)(ldsb + MISC_OFF);
    const int wave = __builtin_amdgcn_readfirstlane((int)(threadIdx.x >> 6)); __builtin_assume(wave >= 0 && wave < NWAVES);
#define lane (lane_id())
#define tid (wave * 64 + lane_id())
    const int G = gridDim.x, bid = blockIdx.x;
#define gw (bid * NWAVES + wave)
#define NGW (G * NWAVES)
    unsigned char* ws = args.ws;
    gu32* ctl = (gu32*)(ws + WS_CTL);
#define I_(k) (args.in[k])
#define Xin I_(0)
#define cvec I_(1)
#define ctx I_(2)
#define c_ctx I_(3)
#define w_ada I_(4)
#define b_ada I_(5)
#define g_pre_mix I_(6)
#define g_post_mix I_(7)
#define g_pre_ffn I_(8)
#define g_post_ffn I_(9)
#define w_in I_(10)
#define ln_v_g I_(11)
#define ln_v_b I_(12)
#define w_s I_(13)
#define b_s I_(14)
#define g_q I_(15)
#define g_k I_(16)
#define g_out_a I_(17)
#define g_out_b I_(18)
#define w_out I_(19)
#define w_up I_(20)
#define conv_w I_(21)
#define conv_b I_(22)
#define w_down I_(23)
#define out (args.out)
#define mods ((float*)(ws + WS_MODS))
#define rope ((float*)(ws + WS_ROPE))
#define lnst ((float*)(ws + WS_LNST))
#define part ((float*)(ws + WS_PART))
#define win_t ((bf16*)(ws + WS_WIN))
#define wout_t ((bf16*)(ws + WS_WOUT))
#define wup_t ((bf16*)(ws + WS_WUP))
#define wdn_t ((bf16*)(ws + WS_WDN))
#define Hb ((bf16*)(ws + WS_H))
#define Zb ((bf16*)(ws + WS_Z))
#define Qn ((bf16*)(ws + WS_Q))
#define Kn ((bf16*)(ws + WS_K))
#define Vn ((bf16*)(ws + WS_V))
#define MIX ((bf16*)(ws + WS_MIX))
#define Ob ((float*)(ws + WS_O))
#define UPb ((bf16*)(ws + WS_UP))
#define Gb ((bf16*)(ws + WS_G))
    for (int u = tid; u < (LDS_BYTES - LDSCTL_OFF) / 4; u += NWAVES * 64) ((LAS unsigned*)(ldsb + LDSCTL_OFF))[u] = 0u;
    __syncthreads();
    XcdBarrier bar; bar.bar = (unsigned*)(ctl + CW_BAR); bar.x = 0; bar.st = nullptr;
    if (MK_ONE_LAUNCH) bar = xcd_barrier_post((unsigned*)(ctl + CW_BAR), MISC + 8);
#define GRID_BAR() do { if (MK_ONE_LAUNCH) xcd_barrier(bar); } while (0)
    const int lo = args.ph_lo, hi = args.ph_hi;
#ifndef PH_MASK
#define PH_MASK 0xFFFFF
#endif
#define IN(k) (((PH_MASK >> (k)) & 1) && lo <= (k) && (k) < hi)
#define BOTH(k) (IN(k) && IN((k) + 1))

    if (IN(0)) {
        ph_gemv(cvec, c_ctx, w_ada, part, (LAS float*)(ldsb + RING_OFF), tid, bid, G);
        ph_rope_table(rope, tid, bid);
        ph_convert(w_in, w_out, w_up, w_down, win_t, wout_t, wup_t, wdn_t, (LAS float*)(ldsb + RING_OFF + wave * 16384), gw, NGW, lane);
        if (BOTH(0)) GRID_BAR();
    }
    if (IN(1)) { ph_mods_reduce(part, b_ada, mods, (LAS float*)(ldsb + RING_OFF), tid, bid, G); if (BOTH(1)) GRID_BAR(); }
    if (IN(2)) { ph_prenorm(Xin, ctx, g_pre_mix, mods, Hb, gw, NGW, lane); if (BOTH(2)) GRID_BAR(); }
    if (IN(3)) {
        pg8::Gemm g{Hb, win_t, MROWS, INC, DM}; pg8::StaticOrder S; S.init(MROWS, INC, G, bid);
        pg8::EpiBf16<0> E{Zb, INC, nullptr, 0, 0, 1.f};
        pg8::gemm_phase<pg8::EpiBf16<0>, pg8::StaticOrder, PG8_ALIGN, PG8_SP2>(ldsb + RING_OFF, g, S, E, wave);
        if (BOTH(3)) GRID_BAR();
    }
    if (IN(4)) { ph_qk(Zb, g_q, g_k, rope, Qn, Kn, Vn, lnst, gw, NGW, lane); if (BOTH(4)) GRID_BAR(); }
    if (IN(5)) { ph_chunk_mlp(Zb, lnst, ln_v_g, ln_v_b, w_s, b_s, MIX, ldsb + RING_OFF, tid, bid, G); if (BOTH(5)) GRID_BAR(); }
    if (IN(6)) {
        for (int u = bid; u < NHQ * (SEQ / 256); u += G) {
            const int h = u >> 5, qb = u & 31;
            attn::attn_dense_body<attn::bf16>(Qn + (size_t)qb * 256 * BWID + h * HD, Kn + (h >> 2) * HD, Vn + (h >> 2) * HD, MIX + (size_t)qb * 256 * DM + AW + h * HD, MROWS, (char*)lds + RING_OFF, wave);
            __syncthreads();
        }
        if (BOTH(6)) GRID_BAR();
    }
    if (IN(7)) { ph_mixnorm(MIX, g_out_a, g_out_b, gw, NGW, lane); if (BOTH(7)) GRID_BAR(); }
    if (IN(8)) {
        pg8::Gemm g{MIX, wout_t, SEQ, DM, DM}; pg8::StaticOrder S; S.init(SEQ, DM, G, bid);
        pg8::EpiF32 E{Ob, DM, nullptr};
        pg8::gemm_phase<pg8::EpiF32, pg8::StaticOrder, PG8_ALIGN, PG8_SP2>(ldsb + RING_OFF, g, S, E, wave);
        if (BOTH(8)) GRID_BAR();
    }
    if (IN(9)) { ph_postmix(Ob, Xin, g_post_mix, g_pre_ffn, mods, out, Hb, (LAS float*)(ldsb + RING_OFF), tid, gw, NGW, lane); if (BOTH(9)) GRID_BAR(); }
    if (IN(10)) {
        pg8::Gemm g{Hb, wup_t, SEQ, UPC, DM}; pg8::StaticOrder S; S.init(SEQ, UPC, G, bid);
        pg8::EpiBf16<0> E{UPb, UPC, nullptr, 0, 0, 1.f};
        pg8::gemm_phase<pg8::EpiBf16<0>, pg8::StaticOrder, PG8_ALIGN, PG8_SP2>(ldsb + RING_OFF, g, S, E, wave);
        if (BOTH(10)) GRID_BAR();
    }
    if (IN(11)) { ph_conv(UPb, conv_w, conv_b, Gb, bid * (NWAVES * 64) + tid, G * NWAVES * 64); if (BOTH(11)) GRID_BAR(); }
    if (IN(12)) {
        pg8::Gemm g{Gb, wdn_t, SEQ, DM, DFF}; pg8::StaticOrder S; S.init(SEQ, DM, G, bid);
        pg8::EpiF32 E{Ob, DM, nullptr};
        pg8::gemm_phase<pg8::EpiF32, pg8::StaticOrder, PG8_ALIGN, PG8_SP2>(ldsb + RING_OFF, g, S, E, wave);
        if (BOTH(12)) GRID_BAR();
    }
    if (IN(13)) { ph_final(Ob, g_post_ffn, mods, out, gw, NGW, lane); }
#undef IN
#undef BOTH
#undef GRID_BAR
#undef tid
#undef lane
#undef gw
#undef NGW
#undef Xin
#undef cvec
#undef ctx
#undef c_ctx
#undef w_ada
#undef b_ada
#undef g_pre_mix
#undef g_post_mix
#undef g_pre_ffn
#undef g_post_ffn
#undef w_in
#undef ln_v_g
#undef ln_v_b
#undef w_s
#undef b_s
#undef g_q
#undef g_k
#undef g_out_a
#undef g_out_b
#undef w_out
#undef w_up
#undef conv_w
#undef conv_b
#undef w_down
#undef out
#undef mods
#undef rope
#undef lnst
#undef part
#undef win_t
#undef wout_t
#undef wup_t
#undef wdn_t
#undef Hb
#undef Zb
#undef Qn
#undef Kn
#undef Vn
#undef MIX
#undef Ob
#undef UPb
#undef Gb
}

extern "C" void kernel_launch(void* const* d_in, const int* in_sizes, int n_in, void* d_out, int out_size, void* d_ws, size_t ws_size, hipStream_t stream) {
    static int grid = 0;
    if (grid == 0) {
        if (n_in != 24 || in_sizes[0] != SEQ * DM || out_size != SEQ * DM || ws_size < WS_END) { fprintf(stderr, "kernel_launch: unexpected shapes: n_in %d in0 %d out %d ws %zu (need %zu)\n", n_in, n_in > 0 ? in_sizes[0] : -1, out_size, ws_size, (size_t)WS_END); grid = -1; return; }
        int dev = 0, cus = 0, per_cu = 0;
        if (hipGetDevice(&dev) != hipSuccess || hipDeviceGetAttribute(&cus, hipDeviceAttributeMultiprocessorCount, dev) != hipSuccess) { grid = -1; return; }
        if (hipFuncSetAttribute((const void*)skel_fwd, hipFuncAttributeMaxDynamicSharedMemorySize, LDS_BYTES) != hipSuccess) { fprintf(stderr, "kernel_launch: hipFuncSetAttribute failed\n"); grid = -1; return; }
        if (hipOccupancyMaxActiveBlocksPerMultiprocessor(&per_cu, (const void*)skel_fwd, NWAVES * 64, LDS_BYTES) != hipSuccess || per_cu < 1) fprintf(stderr, "kernel_launch: occupancy query says %d\n", per_cu);
        (void)hipGetLastError();
        grid = cus;
    }
    if (grid < 0) return;
    if (hipMemsetAsync((char*)d_ws + WS_CTL, 0, CTL_ZERO_BYTES, stream) != hipSuccess) return;
    Args a{};
    for (int i = 0; i < 24; ++i) a.in[i] = (const float*)d_in[i];
    a.out = (float*)d_out; a.ws = (unsigned char*)d_ws;
#if MK_ONE_LAUNCH
    a.ph_lo = 0; a.ph_hi = NPHASE;
    hipLaunchKernelGGL(skel_fwd, dim3(grid), dim3(NWAVES * 64), LDS_BYTES, stream, a);
#else
    for (int ph = 0; ph < NPHASE; ++ph) { a.ph_lo = ph; a.ph_hi = ph + 1; hipLaunchKernelGGL(skel_fwd, dim3(grid), dim3(NWAVES * 64), LDS_BYTES, stream, a); }
#endif
    const hipError_t le = hipPeekAtLastError();
    if (le != hipSuccess) fprintf(stderr, "kernel_launch: launch failed: %s\n", hipGetErrorName(le));
}
```

```cpp
#include <hip/hip_runtime.h>
#include <cstdio>
#include <cstdint>
__device__ __forceinline__ int lane_id() { const int l = (int)__builtin_amdgcn_mbcnt_hi(~0u, __builtin_amdgcn_mbcnt_lo(~0u, 0u)); __builtin_assume(l >= 0 && l < 64); return l; }
namespace pg8 {
#define PG8_LAS __attribute__((address_space(3)))
typedef unsigned short bf16_t;
typedef short bf16x8 __attribute__((ext_vector_type(8)));
typedef float f32x4 __attribute__((ext_vector_type(4)));
typedef unsigned u32x4 __attribute__((ext_vector_type(4)));
constexpr int BM = 256, BK = 64, HALF = 128, HTB = HALF * BK * 2  , STAGE_BYTES = 8 * HTB, NXCD = 8, WGM = 8;

__host__ __device__ __forceinline__ int lds_byte(int r, int c) { const int st = (r >> 4) * 2 + (c >> 5), rr = r & 15, cc = c & 31, ob = rr * 64 + cc * 2; return st * 1024 + (ob ^ (((ob >> 9) & 1) << 5)); }
__host__ __device__ __forceinline__ void stage_rc(int b, int& R, int& C) { const int st = b / 1024, sb = b % 1024, swz = sb ^ (((sb >> 9) & 1) << 5); R = (st >> 1) * 16 + swz / 64; C = (st & 1) * 32 + (swz % 64) / 2; }
__host__ __device__ __forceinline__ int perm32(int rho) { const int n = rho >> 4, i = rho & 15; return 8 * (i >> 2) + 4 * n + (i & 3); }

struct Unit { int pm, pn; };
struct Gemm { const bf16_t* A; const bf16_t* Bt; int M, N, K; };

struct StaticOrder {
    int nM, nN, nwg, G, c;
    __host__ __device__ void init(int M, int N, int G_, int c_) { nM = M / BM; nN = N / BM; nwg = nM * nN; G = G_; c = c_; }
    __host__ __device__ bool next(int i, Unit& u) const {
        const long L = (long)i * G + c; if (L >= nwg) return false;
        int wgid = (int)L; { const int q = nwg / NXCD, r = nwg % NXCD, xcd = wgid % NXCD, off = wgid / NXCD; wgid = (xcd < r ? xcd * (q + 1) : r * (q + 1) + (xcd - r) * q) + off; }
        const int nig = WGM * nN, gid = wgid / nig, fm = gid * WGM, gsz = (nM - fm) < WGM ? (nM - fm) : WGM;
        u.pm = fm + ((wgid % nig) % gsz); u.pn = (wgid % nig) / gsz; return true;
    }
    __device__ __forceinline__ void a_ready(const Unit&) const {}
    __device__ __forceinline__ void done(const Unit&) const {}
};

struct InOrder : StaticOrder {
    __host__ __device__ void init(int G_, int c_) { StaticOrder::init(32 * BM, 28 * BM, G_, c_); }
    __host__ __device__ bool next(int i, Unit& u) const {
        const long L = (long)i * G + c; if (L >= nwg + 4) return false;
        if (L >= nwg) { u.pm = 32; u.pn = 24 + (int)(L - nwg); return true; }
        return StaticOrder::next(i, u);
    }
};
__device__ __forceinline__ unsigned cvt_pk_bf16(float lo, float hi) { unsigned r; asm volatile("v_cvt_pk_bf16_f32 %0, %1, %2" : "=v"(r) : "v"(lo), "v"(hi)); return r; }
typedef float f32x2 __attribute__((ext_vector_type(2)));
__device__ __forceinline__ f32x2 gelu_pk(f32x2 v) {
    const f32x2 av = __builtin_elementwise_abs(v), d = av * 0.2316418882f + 1.0f;
    f32x2 t; t.x = __builtin_amdgcn_rcpf(d.x); t.y = __builtin_amdgcn_rcpf(d.y);
    f32x2 q = t * 0.5307027145f + (-0.7265760135f); q = q * t + 0.7107068705f; q = q * t + (-0.142248368f); q = q * t + 0.127414796f; q = q * t;
    const f32x2 s = (v * v) * (-0.72134752044f);
    f32x2 e; e.x = __builtin_amdgcn_exp2f(s.x); e.y = __builtin_amdgcn_exp2f(s.y);
    const f32x2 m = v * (q * e), r = v - m;
    f32x2 o; o.x = v.x < 0.f ? m.x : r.x; o.y = v.y < 0.f ? m.y : r.y; return o;
}

template <int ACT  > struct EpiBf16 {
    static constexpr bool PERM = true, AFTER_DRAIN = false; static_assert(ACT == 0 || ACT == 1, "EpiBf16: ACT is 0 (none) or 1 (gelu_pk)");
    bf16_t* O; int ldc; const float* bias; int split_cols; size_t split_stride; float scale0;
    __device__ __forceinline__ void operator()(const f32x4 (&acc)[2][2][4][2], const Unit& u, int wr, int wc, int fr, int fq) const {
        const int row0 = u.pm * BM + wr * 64 + fr; int colt = u.pn * BM; bf16_t* base = O;
        float sc = 1.f; if (split_cols) { const int t = colt / split_cols; base += (size_t)t * split_stride; colt -= t * split_cols; if (t == 0) sc = scale0; }
        const int col0 = colt + wc * 32 + 8 * fq, bcol0 = u.pn * BM + wc * 32 + 8 * fq;
        f32x4 bv[2][2];
#pragma unroll
        for (int bj = 0; bj < 2; ++bj)
#pragma unroll
            for (int n = 0; n < 2; ++n) bv[bj][n] = bias ? *(const f32x4*)(bias + bcol0 + bj * HALF + 4 * n) : (f32x4){0.f, 0.f, 0.f, 0.f};
#pragma unroll
        for (int ai = 0; ai < 2; ++ai)
#pragma unroll
            for (int m = 0; m < 4; ++m) { bf16_t* rowp = base + (size_t)(row0 + ai * HALF + m * 16) * ldc + col0;
#pragma unroll
                for (int bj = 0; bj < 2; ++bj) { f32x4 v0 = acc[ai][bj][m][0] + bv[bj][0], v1 = acc[ai][bj][m][1] + bv[bj][1];
                    if (ACT == 1) { f32x2 a = gelu_pk((f32x2){v0[0], v0[1]}), b = gelu_pk((f32x2){v0[2], v0[3]}), c = gelu_pk((f32x2){v1[0], v1[1]}), d = gelu_pk((f32x2){v1[2], v1[3]});
                        v0 = (f32x4){a.x, a.y, b.x, b.y}; v1 = (f32x4){c.x, c.y, d.x, d.y}; }
                    v0 = v0 * sc; v1 = v1 * sc; u32x4 w; w.x = cvt_pk_bf16(v0[0], v0[1]); w.y = cvt_pk_bf16(v0[2], v0[3]); w.z = cvt_pk_bf16(v1[0], v1[1]); w.w = cvt_pk_bf16(v1[2], v1[3]);
                    *(u32x4*)(rowp + bj * HALF) = w; } }
    }
};
struct EpiF32 {
    static constexpr bool PERM = false, AFTER_DRAIN = false;
    float* C; int ldc; const float* bias;
    __device__ __forceinline__ void operator()(const f32x4 (&acc)[2][2][4][2], const Unit& u, int wr, int wc, int fr, int fq) const {
        const int row0 = u.pm * BM + wr * 64 + fr, col0 = u.pn * BM + wc * 32 + 4 * fq;
        f32x4 bv[2][2];
#pragma unroll
        for (int bj = 0; bj < 2; ++bj)
#pragma unroll
            for (int n = 0; n < 2; ++n) bv[bj][n] = bias ? *(const f32x4*)(bias + col0 + bj * HALF + n * 16) : (f32x4){0.f, 0.f, 0.f, 0.f};
#pragma unroll
        for (int ai = 0; ai < 2; ++ai)
#pragma unroll
            for (int m = 0; m < 4; ++m) { float* rowp = C + (size_t)(row0 + ai * HALF + m * 16) * ldc + col0;
#pragma unroll
                for (int bj = 0; bj < 2; ++bj)
#pragma unroll
                    for (int n = 0; n < 2; ++n) *(f32x4*)(rowp + bj * HALF + n * 16) = acc[ai][bj][m][n] + bv[bj][n]; }
    }
};

template <class Epi, class Sched, bool ALIGN_EPI = false, bool SP2 = false>
__device__ __forceinline__ void gemm_phase(PG8_LAS unsigned char* lds, const Gemm g, const Sched& S, const Epi& E, const int wave_) {
    const int lane = lane_id(), wid = wave_; __builtin_assume(lane >= 0 && lane < 64); __builtin_assume(wid >= 0 && wid < 8);
  const int tid = wid * 64 + lane, wr = wid >> 2, wc = wid & 3, fr = lane & 15, fq = lane >> 4;
    const int K = g.K, nt = K / BK;
    unsigned voffA[2], voffB[2];
#pragma unroll
    for (int i = 0; i < 2; ++i) { int R, C; stage_rc(tid * 16 + i * 8192, R, C); const int Rb = Epi::PERM ? ((R & ~31) + perm32(R & 31)) : R;
        voffA[i] = (unsigned)(R * K + C) * 2u; voffB[i] = (unsigned)(Rb * K + C) * 2u; }
    const size_t kstep = (size_t)(BK * 2);
    const size_t hstep = (size_t)HALF * K * 2;
    const size_t tstep = 2 * hstep;
    const unsigned ldsw = (unsigned)wid * 1024u;
    const int aoff = lds_byte(wr * 64 + fr, fq * 8), boff = lds_byte(wc * 32 + fr, fq * 8);
#define PG8_SA(b, h) (((b) * 2 + (h)) * HTB)
#define PG8_SB(b, h) ((4 + (b) * 2 + (h)) * HTB)
#define PG8_STAGE(bufoff, gbase, voff) do { _Pragma("unroll") for (int _i = 0; _i < 2; ++_i) \
        __builtin_amdgcn_global_load_lds((const unsigned*)((const char*)(gbase) + (voff)[_i]), (PG8_LAS unsigned*)(lds + (bufoff) + ldsw + _i * 8192), 16, 0, 0); } while (0)
#define PG8_LDA(dst, b, h) do { _Pragma("unroll") for (int m = 0; m < 4; ++m) _Pragma("unroll") for (int k = 0; k < 2; ++k) dst[m][k] = *(const PG8_LAS bf16x8*)(lds + PG8_SA(b, h) + aoff + m * 2048 + k * 1024); } while (0)
#define PG8_LDB(dst, b, h) do { _Pragma("unroll") for (int n = 0; n < 2; ++n) _Pragma("unroll") for (int k = 0; k < 2; ++k) dst[n][k] = *(const PG8_LAS bf16x8*)(lds + PG8_SB(b, h) + boff + n * 2048 + k * 1024); } while (0)
#define PG8_MMA(ai, bj, At, Bt) do { __builtin_amdgcn_s_setprio(1); _Pragma("unroll") for (int m = 0; m < 4; ++m) _Pragma("unroll") for (int n = 0; n < 2; ++n) _Pragma("unroll") for (int k = 0; k < 2; ++k) \
        acc[ai][bj][m][n] = __builtin_amdgcn_mfma_f32_16x16x32_bf16(Bt[n][k], At[m][k], acc[ai][bj][m][n], 0, 0, 0); __builtin_amdgcn_s_setprio(0); } while (0)
#define PG8_WAIT_V(n) asm volatile("s_waitcnt vmcnt(" #n ")" ::: "memory")
#define PG8_WAIT_L(n) asm volatile("s_waitcnt lgkmcnt(" #n ")" ::: "memory")
#define PG8_BAR __builtin_amdgcn_s_barrier()
#define PG8_SCHED __builtin_amdgcn_sched_barrier(0)
    Unit cur, nxt; int ui = 0;
    if (!S.next(0, cur)) return;
    f32x4 acc[2][2][4][2];
#pragma unroll
    for (int a = 0; a < 2; ++a)
#pragma unroll
        for (int b = 0; b < 2; ++b)
#pragma unroll
            for (int m = 0; m < 4; ++m)
#pragma unroll
                for (int n = 0; n < 2; ++n) acc[a][b][m][n] = (f32x4){0.f, 0.f, 0.f, 0.f};
    bf16x8 At[4][2], B0[2][2], B1[2][2];
    const char* cA = (const char*)g.A + (size_t)cur.pm * tstep; const char* cB = (const char*)g.Bt + (size_t)cur.pn * tstep;
    S.a_ready(cur);
    if constexpr (SP2) {
        PG8_STAGE(PG8_SB(0, 0), cB, voffB); PG8_STAGE(PG8_SB(0, 1), cB + hstep, voffB); PG8_STAGE(PG8_SA(0, 0), cA, voffA); PG8_STAGE(PG8_SA(0, 1), cA + hstep, voffA);
        if (wr == 1) PG8_BAR;
        PG8_WAIT_V(2); PG8_BAR;
        PG8_STAGE(PG8_SB(1, 0), cB + kstep, voffB); PG8_STAGE(PG8_SA(1, 0), cA + kstep, voffA); PG8_STAGE(PG8_SB(1, 1), cB + hstep + kstep, voffB);
        PG8_WAIT_V(6); PG8_BAR;
    } else {
        PG8_STAGE(PG8_SB(0, 0), cB, voffB); PG8_STAGE(PG8_SA(0, 0), cA, voffA); PG8_STAGE(PG8_SB(0, 1), cB + hstep, voffB); PG8_STAGE(PG8_SA(0, 1), cA + hstep, voffA);
        if (wr == 1) PG8_BAR;
        PG8_WAIT_V(4); PG8_BAR;
        PG8_STAGE(PG8_SB(1, 0), cB + kstep, voffB); PG8_STAGE(PG8_SA(1, 0), cA + kstep, voffA); PG8_STAGE(PG8_SB(1, 1), cB + hstep + kstep, voffB);
        PG8_WAIT_V(6); PG8_BAR;
    }
    for (;;) {
        const bool has_next = S.next(ui + 1, nxt);
        const char* nA = has_next ? (const char*)g.A + (size_t)nxt.pm * tstep : cA; const char* nB = has_next ? (const char*)g.Bt + (size_t)nxt.pn * tstep : cB;
        for (int t = 0; t < nt; t += 2) {
            const bool last = (t == nt - 2);
            const char* a1 = cA + (size_t)(t + 1) * kstep;
            const char* a2 = last ? nA : cA + (size_t)(t + 2) * kstep; const char* b2 = last ? nB : cB + (size_t)(t + 2) * kstep;
            const char* a3 = a2 + kstep; const char* b3 = b2 + kstep;
            if (last && has_next) S.a_ready(nxt);
            if constexpr (SP2) {
            PG8_LDB(B0, 0, 0); PG8_LDB(B1, 0, 1); PG8_SCHED; PG8_LDA(At, 0, 0); PG8_STAGE(PG8_SA(1, 1), a1 + hstep, voffA);
            PG8_WAIT_V(8); PG8_WAIT_L(0); PG8_BAR; PG8_MMA(0, 0, At, B0); PG8_MMA(0, 1, At, B1); PG8_BAR; PG8_SCHED;
            PG8_LDA(At, 0, 1); PG8_STAGE(PG8_SB(0, 0), b2, voffB); PG8_STAGE(PG8_SB(0, 1), b2 + hstep, voffB); PG8_STAGE(PG8_SA(0, 0), a2, voffA);
            PG8_WAIT_V(8); PG8_WAIT_L(0); PG8_BAR; PG8_MMA(1, 0, At, B0); PG8_MMA(1, 1, At, B1); PG8_BAR; PG8_SCHED;
            PG8_LDB(B0, 1, 0); PG8_LDB(B1, 1, 1); PG8_SCHED; PG8_LDA(At, 1, 0); PG8_STAGE(PG8_SA(0, 1), a2 + hstep, voffA);
            PG8_WAIT_V(8); PG8_WAIT_L(0); PG8_BAR; PG8_MMA(0, 0, At, B0); PG8_MMA(0, 1, At, B1); PG8_BAR; PG8_SCHED;
            PG8_LDA(At, 1, 1); PG8_STAGE(PG8_SB(1, 0), b3, voffB); PG8_STAGE(PG8_SB(1, 1), b3 + hstep, voffB); PG8_STAGE(PG8_SA(1, 0), a3, voffA);
            PG8_WAIT_V(8); PG8_WAIT_L(0); PG8_BAR; PG8_MMA(1, 0, At, B0); PG8_MMA(1, 1, At, B1); PG8_BAR; PG8_SCHED;
            } else {
            PG8_LDB(B0, 0, 0); PG8_SCHED; PG8_LDA(At, 0, 0); PG8_STAGE(PG8_SA(1, 1), a1 + hstep, voffA);
            PG8_WAIT_L(8); PG8_BAR; PG8_WAIT_L(0); PG8_MMA(0, 0, At, B0); PG8_BAR; PG8_SCHED;
            PG8_LDB(B1, 0, 1); PG8_STAGE(PG8_SB(0, 0), b2, voffB);
            PG8_BAR; PG8_WAIT_L(0); PG8_MMA(0, 1, At, B1); PG8_BAR;
            PG8_LDA(At, 0, 1); PG8_STAGE(PG8_SA(0, 0), a2, voffA);
            PG8_BAR; PG8_WAIT_L(0); PG8_MMA(1, 0, At, B0); PG8_BAR; PG8_SCHED;
            PG8_STAGE(PG8_SB(0, 1), b2 + hstep, voffB);
            PG8_WAIT_V(6); PG8_BAR; PG8_MMA(1, 1, At, B1); PG8_BAR;
            PG8_LDB(B0, 1, 0); PG8_SCHED; PG8_LDA(At, 1, 0); PG8_STAGE(PG8_SA(0, 1), a2 + hstep, voffA);
            PG8_WAIT_L(8); PG8_BAR; PG8_WAIT_L(0); PG8_MMA(0, 0, At, B0); PG8_BAR; PG8_SCHED;
            PG8_LDB(B1, 1, 1); PG8_STAGE(PG8_SB(1, 0), b3, voffB);
            PG8_BAR; PG8_WAIT_L(0); PG8_MMA(0, 1, At, B1); PG8_BAR;
            PG8_LDA(At, 1, 1); PG8_STAGE(PG8_SA(1, 0), a3, voffA);
            PG8_BAR; PG8_WAIT_L(0); PG8_MMA(1, 0, At, B0); PG8_BAR; PG8_SCHED;
            PG8_STAGE(PG8_SB(1, 1), b3 + hstep, voffB);
            PG8_WAIT_V(6); PG8_BAR; PG8_MMA(1, 1, At, B1); PG8_BAR;
            }
        }
        if constexpr (ALIGN_EPI) { if (wr == 0) PG8_BAR; }
        if constexpr (!Epi::AFTER_DRAIN) { E(acc, cur, wr, wc, fr, fq); S.done(cur); }
        if (!has_next) break;
#pragma unroll
        for (int a = 0; a < 2; ++a)
#pragma unroll
            for (int b = 0; b < 2; ++b)
#pragma unroll
                for (int m = 0; m < 4; ++m)
#pragma unroll
                    for (int n = 0; n < 2; ++n) acc[a][b][m][n] = (f32x4){0.f, 0.f, 0.f, 0.f};
        cur = nxt; cA = nA; cB = nB; ++ui;
        if constexpr (ALIGN_EPI) { if (wr == 1) PG8_BAR; }
    }
    PG8_WAIT_V(0);
    if constexpr (!ALIGN_EPI) { if (wr == 0) PG8_BAR; }
    PG8_BAR;
    if constexpr (Epi::AFTER_DRAIN) { E.fused(acc, cur, wr, wc, fr, fq, lds, wid, lane); S.done(cur); }
#undef PG8_SA
#undef PG8_SB
#undef PG8_STAGE
#undef PG8_LDA
#undef PG8_LDB
#undef PG8_MMA
#undef PG8_WAIT_V
#undef PG8_WAIT_L
#undef PG8_BAR
#undef PG8_SCHED
}
}

#ifndef PG8_SP2
#define PG8_SP2 true
#endif
#ifndef PG8_ALIGN
#define PG8_ALIGN true
#endif

namespace attn {
typedef unsigned short bf16;
constexpr int   D = 128, NW = 8, QBLK = 32, KVBLK = 64;
constexpr float SCALE = 0.088388347648318440f;
constexpr float THR = 8.f;
constexpr int SDEPTH = 2;
constexpr int LDQ = 2048, LDK = 512, LDO = 4096;
constexpr size_t SHM_V = KVBLK * D * 2, SHM_K = KVBLK * D * 2, SHM_ATTN = 2 * SHM_V + 2 * SHM_K + NW * 64 * 4;
using bf16x8 = __attribute__((ext_vector_type(8))) short;
using s16x4  = __attribute__((ext_vector_type(4))) short;
using f32x16 = __attribute__((ext_vector_type(16))) float;
using f32x8  = __attribute__((ext_vector_type(8))) float;
using u32x4  = __attribute__((ext_vector_type(4))) unsigned;
#define KSWZ(row, colB) ((row) * 256 + ((colB) ^ (((row) & 7) << 4)))
#define SBAR() __builtin_amdgcn_sched_barrier(0)
__device__ __forceinline__ int crow(int r, int hi) { return (r & 3) + 8 * (r >> 2) + 4 * hi; }
__device__ __forceinline__ unsigned cvtpk(float lo, float hi) {
  unsigned r; asm volatile("v_cvt_pk_bf16_f32 %0, %1, %2" : "=v"(r) : "v"(lo), "v"(hi)); return r;
}
__device__ __forceinline__ bf16 f2bf_rne(float f) { unsigned u = __builtin_bit_cast(unsigned, f); return (bf16)((u + 0x7fffu + ((u >> 16) & 1u)) >> 16); }
template <typename TIn> struct Stage;
template <> struct Stage<bf16>  { using T = bf16x8;
  __device__ static __forceinline__ T ld8(const bf16* p) { return *reinterpret_cast<const bf16x8*>(p); }
  __device__ static __forceinline__ bf16x8 tobf(T x) { return x; } };
template <> struct Stage<float> { using T = f32x8;
  __device__ static __forceinline__ T ld8(const float* p) { return *reinterpret_cast<const f32x8*>(p); }
  __device__ static __forceinline__ bf16x8 tobf(T x) {
    u32x4 w = {cvtpk(x[0], x[1]), cvtpk(x[2], x[3]), cvtpk(x[4], x[5]), cvtpk(x[6], x[7])}; return *reinterpret_cast<bf16x8*>(&w); } };

__device__ __forceinline__ void partialSM(f32x16& p0, f32x16& p1, float& m_reg, float& mn, float& alpha) {
  constexpr float C = SCALE * 1.4426950408889634f;
  float pmax = p0[0]; for (int r = 1; r < 16; ++r) pmax = fmaxf(pmax, p0[r]); for (int r = 0; r < 16; ++r) pmax = fmaxf(pmax, p1[r]);
  { auto rr = __builtin_amdgcn_permlane32_swap(__float_as_uint(pmax), __float_as_uint(pmax), false, false);
    pmax = fmaxf(__uint_as_float(rr[0]), __uint_as_float(rr[1])); }
  if (__builtin_expect(__all(pmax - m_reg <= THR / SCALE), 1)) { mn = m_reg; alpha = 1.f; }
  else { mn = fmaxf(m_reg, pmax); alpha = __builtin_amdgcn_exp2f((m_reg - mn) * C); m_reg = mn; }
  float mnC = -mn * C;
  for (int r = 0; r < 16; ++r) p0[r] = fmaf(p0[r], C, mnC); for (int r = 0; r < 16; ++r) p1[r] = fmaf(p1[r], C, mnC);
  for (int r = 0; r < 16; ++r) p0[r] = __builtin_amdgcn_exp2f(p0[r]);
}
__device__ __forceinline__ void finishSM(f32x16& p0, f32x16& p1, float alpha, float& l_reg, bf16x8& pa0, bf16x8& pa1, bf16x8& pa2, bf16x8& pa3) {
  for (int r = 0; r < 16; ++r) p1[r] = __builtin_amdgcn_exp2f(p1[r]);
  float ps = 0; for (int r = 0; r < 16; ++r) ps += p0[r]; for (int r = 0; r < 16; ++r) ps += p1[r];
  { auto rr = __builtin_amdgcn_permlane32_swap(__float_as_uint(ps), __float_as_uint(ps), false, false);
    ps = __uint_as_float(rr[0]) + __uint_as_float(rr[1]); }
  l_reg = l_reg * alpha + ps;
#define PK4(P, BASE, OUT) do { unsigned a0 = cvtpk(P[BASE + 0], P[BASE + 1]), a1 = cvtpk(P[BASE + 2], P[BASE + 3]);   \
    unsigned b0 = cvtpk(P[BASE + 4], P[BASE + 5]), b1 = cvtpk(P[BASE + 6], P[BASE + 7]);                              \
    auto r0 = __builtin_amdgcn_permlane32_swap(a0, b0, false, false); auto r1 = __builtin_amdgcn_permlane32_swap(a1, b1, false, false); \
    u32x4 w = {r0[0], r1[0], r0[1], r1[1]}; OUT = *reinterpret_cast<bf16x8*>(&w); } while (0)
  PK4(p0, 0, pa0); PK4(p0, 8, pa1); PK4(p1, 0, pa2); PK4(p1, 8, pa3);
#undef PK4
}
__device__ __forceinline__ void qkt(f32x16& p0, f32x16& p1, const bf16* Ks, const bf16x8* qr, int r32, int hi) {
  p0 = f32x16{}; p1 = f32x16{};
  for (int d0 = 0; d0 < 8; ++d0) { int cb = (d0 * 16 + hi * 8) * 2;
    bf16x8 b0 = *reinterpret_cast<const bf16x8*>((const char*)Ks + KSWZ(r32, cb));
    bf16x8 b1 = *reinterpret_cast<const bf16x8*>((const char*)Ks + KSWZ(32 + r32, cb));
    p0 = __builtin_amdgcn_mfma_f32_32x32x16_bf16(b0, qr[d0], p0, 0, 0, 0);
    p1 = __builtin_amdgcn_mfma_f32_32x32x16_bf16(b1, qr[d0], p1, 0, 0, 0); }
}
__device__ __forceinline__ int v_st(int k, int c) { const int kk = (k & ~0xC) | ((k & 4) << 1) | ((k & 8) >> 1); return ((kk >> 3) * 4 + (c >> 5)) * 512 + ((kk & 7) * 32 + (c & 31)) * 2; }
__device__ __forceinline__ int v_rd_base(int lane) { return ((lane & 3) << 3) | (((lane >> 2) & 3) << 6) | (((lane >> 4) & 1) << 5) | (((lane >> 5) & 1) << 8); }
constexpr int v_rd_off(int d0, int ks, int half) { return d0 * 512 + ks * 4096 + half * 2048; }
template <int OFF> __device__ __forceinline__ s16x4 tr_read(int vb) {
  s16x4 r; asm volatile("ds_read_b64_tr_b16 %0, %1 offset:%2" : "=&v"(r) : "v"(vb), "i"(OFF) : "memory"); return r;
}
template <int D0> __device__ __forceinline__ void pv_one(f32x16& od, int vb, bf16x8 pa0, bf16x8 pa1, bf16x8 pa2, bf16x8 pa3) {
  const s16x4 l0 = tr_read<v_rd_off(D0, 0, 0)>(vb), h0 = tr_read<v_rd_off(D0, 0, 1)>(vb), l1 = tr_read<v_rd_off(D0, 1, 0)>(vb), h1 = tr_read<v_rd_off(D0, 1, 1)>(vb);
  const s16x4 l2 = tr_read<v_rd_off(D0, 2, 0)>(vb), h2 = tr_read<v_rd_off(D0, 2, 1)>(vb), l3 = tr_read<v_rd_off(D0, 3, 0)>(vb), h3 = tr_read<v_rd_off(D0, 3, 1)>(vb);
  asm volatile("s_waitcnt lgkmcnt(0)" ::: "memory"); SBAR();
#define PK(L, H) (bf16x8){L[0], L[1], L[2], L[3], H[0], H[1], H[2], H[3]}
  od = __builtin_amdgcn_mfma_f32_32x32x16_bf16(pa0, PK(l0, h0), od, 0, 0, 0);
  od = __builtin_amdgcn_mfma_f32_32x32x16_bf16(pa1, PK(l1, h1), od, 0, 0, 0);
  od = __builtin_amdgcn_mfma_f32_32x32x16_bf16(pa2, PK(l2, h2), od, 0, 0, 0);
  od = __builtin_amdgcn_mfma_f32_32x32x16_bf16(pa3, PK(l3, h3), od, 0, 0, 0);
#undef PK
}
__device__ __forceinline__ void pv_d0(f32x16* o, int vb, bf16x8 pa0, bf16x8 pa1, bf16x8 pa2, bf16x8 pa3) {
  pv_one<0>(o[0], vb, pa0, pa1, pa2, pa3); pv_one<1>(o[1], vb, pa0, pa1, pa2, pa3); pv_one<2>(o[2], vb, pa0, pa1, pa2, pa3); pv_one<3>(o[3], vb, pa0, pa1, pa2, pa3);
}

template <typename TQ>
__device__ __forceinline__ void attn_dense_body(const TQ* __restrict__ Qb, const bf16* __restrict__ Kh, const bf16* __restrict__ Vh,
                                                bf16* __restrict__ Ob, int seq, char* lds, const int wave_) {
  using St = Stage<bf16>; using SQ = Stage<TQ>;
  const int lane = lane_id(), wid = wave_; __builtin_assume(lane >= 0 && lane < 64); __builtin_assume(wid >= 0 && wid < 8);
  const int tid = wid * 64 + lane, r32 = lane & 31, hi = lane >> 5;
  bf16* V_lds = (bf16*)lds; bf16* K_lds = (bf16*)(lds + 2 * SHM_V);
  float* ws = (float*)(lds + 2 * SHM_V + 2 * SHM_K) + wid * 64; float* li_l = ws; float* al_l = ws + 32;
  float m_reg = -1e30f, l_reg = 0; f32x16 o[4] = {}; bf16x8 qr[8];
  const TQ* Qw = Qb + (long)(wid * QBLK + r32) * LDQ + hi * 8;
#pragma unroll
  for (int d0 = 0; d0 < 8; ++d0) qr[d0] = SQ::tobf(SQ::ld8(Qw + d0 * 16));
  const int sr = tid >> 4, sc = (tid & 15) * 8, vst0 = v_st(sr, sc), vst1 = v_st(32 + sr, sc);
  const int vb0 = (int)(uintptr_t)V_lds + v_rd_base(lane);
  struct { typename St::T vs0, vs1, ks0, ks1; } sr_[SDEPTH];
#define SLOAD(i, k0) do { sr_[i].vs0 = St::ld8(&Vh[(long)((k0) + sr) * LDK + sc]); sr_[i].vs1 = St::ld8(&Vh[(long)((k0) + 32 + sr) * LDK + sc]); \
    sr_[i].ks0 = St::ld8(&Kh[(long)((k0) + sr) * LDK + sc]); sr_[i].ks1 = St::ld8(&Kh[(long)((k0) + 32 + sr) * LDK + sc]); } while (0)
#define SWRITE(b, i) do { *(bf16x8*)((char*)V_lds + (b) * SHM_V + vst0) = St::tobf(sr_[i].vs0);          \
    *(bf16x8*)((char*)V_lds + (b) * SHM_V + vst1) = St::tobf(sr_[i].vs1); int kc = sc * 2;               \
    *(bf16x8*)((char*)K_lds + (b) * SHM_K + KSWZ(sr, kc)) = St::tobf(sr_[i].ks0);                       \
    *(bf16x8*)((char*)K_lds + (b) * SHM_K + KSWZ(32 + sr, kc)) = St::tobf(sr_[i].ks1); } while (0)
#define SWAIT() do { if constexpr (SDEPTH == 2) asm volatile("s_waitcnt vmcnt(4)" ::: "memory"); else asm volatile("s_waitcnt vmcnt(0)" ::: "memory"); } while (0)
#define RESC(a) do { if (__any((a) < 1.f)) { if (hi == 0) al_l[r32] = (a); asm volatile("s_waitcnt lgkmcnt(0)" ::: "memory"); \
    for (int d = 0; d < 4; ++d) for (int r = 0; r < 16; ++r) o[d][r] *= al_l[crow(r, hi)]; } } while (0)
  f32x16 pA0, pA1, pB0, pB1; float mnA, mnB, alA, alB; bf16x8 pa0, pa1, pa2, pa3; const int NT = seq / KVBLK;
  constexpr int SE = 0, SO = SDEPTH - 1;
  SLOAD(SE, 0); asm volatile("s_waitcnt vmcnt(0)" ::: "memory"); SWRITE(0, SE); __syncthreads();
  qkt(pA0, pA1, K_lds, qr, r32, hi); partialSM(pA0, pA1, m_reg, mnA, alA);
  SLOAD(SO, KVBLK); if constexpr (SDEPTH == 2) { if (2 < NT) SLOAD(SE, 2 * KVBLK); }
  SWAIT(); SWRITE(1, SO); __syncthreads();
  for (int j = 1; j + 1 < NT; j += 2) {
    SBAR(); qkt(pB0, pB1, (bf16*)((char*)K_lds + SHM_K), qr, r32, hi);
    finishSM(pA0, pA1, alA, l_reg, pa0, pa1, pa2, pa3); SBAR();
    SLOAD(SO, (j + SDEPTH) * KVBLK); SBAR();
    pv_d0(o, vb0, pa0, pa1, pa2, pa3); partialSM(pB0, pB1, m_reg, mnB, alB);
    __syncthreads(); SWAIT(); SWRITE(0, SE);
    RESC(alB); __syncthreads();
    SBAR(); qkt(pA0, pA1, K_lds, qr, r32, hi);
    finishSM(pB0, pB1, alB, l_reg, pa0, pa1, pa2, pa3); SBAR();
    if (SDEPTH == 1 || j + 3 < NT) SLOAD(SE, (j + 1 + SDEPTH) * KVBLK); SBAR();
    pv_d0(o, vb0 + (int)SHM_V, pa0, pa1, pa2, pa3); partialSM(pA0, pA1, m_reg, mnA, alA);
    __syncthreads(); SWAIT(); SWRITE(1, SO);
    RESC(alA); __syncthreads();
  }
  SBAR(); qkt(pB0, pB1, (bf16*)((char*)K_lds + SHM_K), qr, r32, hi);
  finishSM(pA0, pA1, alA, l_reg, pa0, pa1, pa2, pa3); SBAR();
  pv_d0(o, vb0, pa0, pa1, pa2, pa3); partialSM(pB0, pB1, m_reg, mnB, alB);
  __syncthreads(); RESC(alB);
  finishSM(pB0, pB1, alB, l_reg, pa0, pa1, pa2, pa3); SBAR();
  pv_d0(o, vb0 + (int)SHM_V, pa0, pa1, pa2, pa3);
  if (hi == 0) li_l[r32] = l_reg; asm volatile("s_waitcnt lgkmcnt(0)" ::: "memory");
  float rli[16];
#pragma unroll
  for (int r = 0; r < 16; ++r) rli[r] = __builtin_amdgcn_rcpf(li_l[crow(r, hi)]);
  bf16* Ow = Ob + (long)(wid * QBLK) * LDO;
#pragma unroll
  for (int r = 0; r < 16; ++r) { int orow = crow(r, hi);
    for (int d0 = 0; d0 < 4; ++d0) Ow[(long)orow * LDO + d0 * 32 + r32] = f2bf_rne(o[d0][r] * rli[r]); }
#undef SLOAD
#undef SWRITE
#undef SWAIT
#undef RESC
}
}

constexpr int NWAVES = 8;
#ifndef MK_ONE_LAUNCH
#define MK_ONE_LAUNCH 1
#endif

constexpr int DM = 4096, SEQ = 8192, CTXN = 256, MROWS = SEQ + CTXN;
constexpr int AW = 2048, BWID = 2048, HD = 128, NHQ = 16, NKVH = 4, KVW = 512;
constexpr int INC = 7168, DFF = 11008, UPC = 2 * DFF;
constexpr int ZQ0 = 4096, ZK0 = 6144, ZV0 = 6656;
constexpr float EPSN = 1e-6f;
constexpr int NMODV = 32768;

constexpr size_t MiB = 1u << 20;
constexpr size_t WS_CTL = 0, CTL_ZERO_BYTES = 1 * MiB;
constexpr size_t WS_MODS = 1 * MiB;
constexpr size_t WS_ROPE = 1 * MiB + 256 * 1024;
constexpr size_t WS_LNST = 2 * MiB;
constexpr size_t WS_PART = 4 * MiB;
constexpr size_t WS_WIN = 16 * MiB, WS_WOUT = 72 * MiB, WS_WUP = 104 * MiB, WS_WDN = 276 * MiB;
constexpr size_t WS_H = 362 * MiB;
constexpr size_t WS_Z = 428 * MiB;
constexpr size_t WS_Q = 544 * MiB, WS_K = 576 * MiB, WS_V = 585 * MiB;
constexpr size_t WS_MIX = 594 * MiB;
constexpr size_t WS_O = 658 * MiB;
constexpr size_t WS_UP = 786 * MiB;
constexpr size_t WS_G = 1130 * MiB;
constexpr size_t WS_END = 1302 * MiB;
constexpr int CW_BAR = 4096;

constexpr int RING_OFF = 0, RING_BYTES = 131072;
constexpr int LDSCTL_OFF = RING_BYTES, MISC_OFF = LDSCTL_OFF + 320;
constexpr int LDS_BYTES = 147456;

#define GAS __attribute__((address_space(1)))
#define LAS __attribute__((address_space(3)))
typedef unsigned short bf16;
typedef unsigned v4u __attribute__((ext_vector_type(4)));
typedef float f32x4 __attribute__((ext_vector_type(4)));
typedef short bf16x8 __attribute__((ext_vector_type(8)));
typedef GAS unsigned gu32;
typedef GAS unsigned long long gu64;
#define RLX_AGENT __ATOMIC_RELAXED, __HIP_MEMORY_SCOPE_AGENT
#define LDS_WAIT() asm volatile("s_waitcnt lgkmcnt(0)" ::: "memory")
#define VM_WAIT() asm volatile("s_waitcnt vmcnt(0)" ::: "memory")
__device__ __forceinline__ unsigned long long rt() { return __builtin_amdgcn_s_memrealtime(); }
__device__ __forceinline__ unsigned f2bf(float f) { unsigned u = __builtin_bit_cast(unsigned, f); return (u + 0x7fffu + ((u >> 16) & 1u)) >> 16; }
__device__ __forceinline__ unsigned pk2(float lo, float hi) { return f2bf(lo) | (f2bf(hi) << 16); }

#define XB_TMO      128
#define XB_XCNT(j)  (256  + 64 * (j))
#define XB_XSUB(j)  (1280 + 64 * (j))
#define XB_XGEN(j)  (2304 + 64 * (j))
#define XB_TOP      3328
#define XB_TOPGEN   3392
#define XCD_BAR_WORDS 3456
#define XB_SPIN_CAP (1u << 18)

__device__ __forceinline__ unsigned xb_ld(unsigned* p)              { return __hip_atomic_load(p, __ATOMIC_RELAXED, __HIP_MEMORY_SCOPE_AGENT); }
__device__ __forceinline__ unsigned xb_add(unsigned* p, unsigned v) { return __hip_atomic_fetch_add(p, v, __ATOMIC_RELAXED, __HIP_MEMORY_SCOPE_AGENT); }
__device__ __forceinline__ unsigned xb_xcc_id() { return (unsigned)__builtin_amdgcn_s_getreg((3 << 11) | 20) & 0xFu; }
#define XB_SPIN(cond, bar) do { unsigned _sp = 0; while (cond) { __builtin_amdgcn_s_sleep(1); \
    if ((++_sp & 255u) == 0u) { if (xb_ld(&(bar)[XB_TMO])) break; if (_sp > XB_SPIN_CAP) { atomicAdd(&(bar)[XB_TMO], 1u); break; } } } } while (0)

struct XcdBarrier {
    unsigned* bar; unsigned x;
    volatile LAS unsigned* st;
};

__device__ __forceinline__ XcdBarrier xcd_barrier_post(unsigned* bar, volatile LAS unsigned* st) {
    XcdBarrier b; b.bar = bar; b.x = xb_xcc_id(); b.st = st;
    if (threadIdx.x == 0) (void)xb_add(&bar[XB_XCNT(b.x)], 1u);
    return b;
}
__device__ __forceinline__ void xcd_barrier_complete(unsigned* bar, unsigned x, unsigned& nloc, unsigned& nx) {
    const unsigned G = gridDim.x * gridDim.y * gridDim.z;
    unsigned sum, cnt, mine, sp = 0u;
    for (;;) {
        sum = 0u; cnt = 0u; mine = 0u;
#pragma unroll
        for (unsigned j = 0; j < 16; ++j) { const unsigned c = xb_ld(&bar[XB_XCNT(j)]); sum += c; cnt += (c > 0u) ? 1u : 0u; mine = (j == x) ? c : mine; }
        if (sum == G) break;
        __builtin_amdgcn_s_sleep(1);
        if ((++sp & 255u) == 0u) { if (xb_ld(&bar[XB_TMO])) break; if (sp > XB_SPIN_CAP) { atomicAdd(&bar[XB_TMO], 1u); break; } }
    }
    nloc = mine > 0u ? mine : 1u; nx = cnt > 0u ? cnt : 1u;
}

__device__ __forceinline__ void xcd_barrier(const XcdBarrier& b) {
    asm volatile("s_waitcnt vmcnt(0)" ::: "memory");
    __syncthreads();
    if (threadIdx.x == 0) {
        unsigned* bar = b.bar;
        __builtin_amdgcn_s_waitcnt(0);
        unsigned nloc = b.st[0], nx = b.st[1];
        if (nloc == 0u) { xcd_barrier_complete(bar, b.x, nloc, nx); b.st[0] = nloc; b.st[1] = nx; }
        const unsigned old = xb_add(&bar[XB_XSUB(b.x)], 1u);
        const unsigned gen = old / nloc;
        if (old + 1u == (gen + 1u) * nloc) {
            __builtin_amdgcn_fence(__ATOMIC_RELEASE, "agent");
            asm volatile("s_waitcnt vmcnt(0)" ::: "memory");
            const unsigned og = xb_add(&bar[XB_TOP], 1u);
            const unsigned tg = og / nx;
            if (og + 1u == (tg + 1u) * nx) xb_add(&bar[XB_TOPGEN], 1u);
            else XB_SPIN(xb_ld(&bar[XB_TOPGEN]) == tg, bar);
            __builtin_amdgcn_fence(__ATOMIC_ACQUIRE, "agent");
            xb_add(&bar[XB_XGEN(b.x)], 1u);
            asm volatile("s_waitcnt vmcnt(0)" ::: "memory");
        } else {
            XB_SPIN(xb_ld(&bar[XB_XGEN(b.x)]) == gen, bar);
            __builtin_amdgcn_fence(__ATOMIC_ACQUIRE, "agent");
            asm volatile("s_waitcnt vmcnt(0)" ::: "memory");
        }
    }
    __syncthreads();
}

typedef float f32x2v __attribute__((ext_vector_type(2)));
typedef unsigned u32x2v __attribute__((ext_vector_type(2)));
typedef float f32x16 __attribute__((ext_vector_type(16)));
__device__ __forceinline__ float wave_sum(float v) {
#pragma unroll
    for (int o = 1; o < 64; o <<= 1) v += __shfl_xor(v, o);
    return v;
}
__device__ __forceinline__ float bflo(unsigned w) { return __uint_as_float(w << 16); }
__device__ __forceinline__ float bfhi(unsigned w) { return __uint_as_float(w & 0xffff0000u); }
__device__ __forceinline__ float bf2f(bf16 b) { return __uint_as_float(((unsigned)b) << 16); }
__device__ __forceinline__ float gelu_erf(float v) { return 0.5f * v * (1.0f + erff(v * 0.70710678118654752f)); }
__device__ __forceinline__ float silu_f(float v) { return v / (1.0f + __expf(-v)); }
__device__ __forceinline__ float dot4(f32x4 a) { return (a.x * a.x + a.y * a.y) + (a.z * a.z + a.w * a.w); }

__device__ __forceinline__ void ph_gemv(const float* c, const float* cx, const float* w_ada, float* part, LAS float* sl, int tid, int bid, int G) {
    for (int k = tid; k < DM; k += NWAVES * 64) { const float a = c[k]; sl[k] = a / (1.0f + expf(-a)); const float b = cx[k]; sl[DM + k] = b / (1.0f + expf(-b)); }
    __syncthreads();
    const int half = tid >> 8, tx = tid & 255;
    for (int it = bid; it < 768; it += G) {
        const int jt = it % 24, ks = it / 24;
        const int j0 = jt * 1024 + tx * 4, kbase = ks * 128 + half * 64;
        const f32x4* wp = (const f32x4*)(w_ada + (size_t)kbase * (6 * DM) + j0);
        f32x4 ac = (f32x4){0.f, 0.f, 0.f, 0.f}, ax = (f32x4){0.f, 0.f, 0.f, 0.f};
#pragma unroll 8
        for (int i = 0; i < 64; ++i) { const f32x4 w = wp[(size_t)i * (6 * DM / 4)]; const float sc = sl[kbase + i], sx = sl[DM + kbase + i]; ac += w * sc; ax += w * sx; }
        float* po = part + (size_t)(ks * 2 + half) * NMODV;
        *(f32x4*)(po + j0) = ac;
        if (jt < 8) *(f32x4*)(po + 6 * DM + j0) = ax;
    }
    __syncthreads();
}
__device__ __forceinline__ void ph_rope_table(float* rope, int tid, int bid) {
    const int gid = bid * (NWAVES * 64) + tid;
    if (gid < 4096) { const int pos = gid >> 5, i = gid & 31; const float fr = powf(10000.0f, -(float)i / 32.0f); const float ang = (float)pos * fr; rope[gid] = cosf(ang); rope[4096 + gid] = sinf(ang); }
}
__device__ __forceinline__ void transpose_item(const float* W, int N, int k0, int n_src0, bf16* WT, int K, int n_dst0, LAS float* scr, int lane) {
#pragma unroll 8
    for (int i = 0; i < 32; ++i) { const int kk = 2 * i + (lane >> 5); scr[kk * 33 + (lane & 31)] = W[(size_t)(k0 + kk) * N + n_src0 + (lane & 31)]; }
    LDS_WAIT(); asm volatile("" ::: "memory");
    const int c = lane & 7;
#pragma unroll
    for (int j = 0; j < 4; ++j) { const int n = (lane >> 3) + 8 * j; const LAS float* s = scr + (8 * c) * 33 + n;
        v4u o; o.x = pk2(s[0 * 33], s[1 * 33]); o.y = pk2(s[2 * 33], s[3 * 33]); o.z = pk2(s[4 * 33], s[5 * 33]); o.w = pk2(s[6 * 33], s[7 * 33]);
        *(GAS v4u*)(WT + (size_t)(n_dst0 + n) * K + k0 + 8 * c) = o; }
    LDS_WAIT(); asm volatile("" ::: "memory");
}
template <int WHICH  >
__device__ __forceinline__ void ph_convert(const float* w_in, const float* w_out, const float* w_up, const float* w_dn, bf16* win_t, bf16* wout_t, bf16* wup_t, bf16* wdn_t,
                                           LAS float* scr, int gw, int NGW, int lane) {
    constexpr int I_IN = (DM / 64) * (INC / 32), I_OUT = (DM / 64) * (DM / 32), I_UP = (DM / 64) * (UPC / 32), I_DN = (DFF / 64) * (DM / 32);
    if constexpr (WHICH == 0) {
        for (int r = gw; r < I_IN; r += NGW) { const int nblk = INC / 32, kb = r / nblk, nb = r % nblk; transpose_item(w_in, INC, 64 * kb, 32 * nb, win_t, DM, 32 * nb, scr, lane); }
    } else if constexpr (WHICH == 1) {
        for (int it = gw; it < I_OUT + I_UP; it += NGW) {
            int r = it;
            if (r < I_OUT) { const int nblk = DM / 32, kb = r / nblk, nb = r % nblk; transpose_item(w_out, DM, 64 * kb, 32 * nb, wout_t, DM, 32 * nb, scr, lane); continue; } r -= I_OUT;
            { const int nblk = UPC / 32, kb = r / nblk, nb = r % nblk; const int T = nb >> 3, w = nb & 7;
              const int src = (w < 4) ? (T * 128 + w * 32) : (DFF + T * 128 + (w - 4) * 32);
              transpose_item(w_up, UPC, 64 * kb, src, wup_t, DM, 32 * nb, scr, lane); }
        }
    } else {
        for (int r = gw; r < I_DN; r += NGW) { const int nblk = DM / 32, kb = r / nblk, nb = r % nblk; transpose_item(w_dn, DM, 64 * kb, 32 * nb, wdn_t, DFF, 32 * nb, scr, lane); }
    }
}
__device__ __forceinline__ void ph_mods_reduce(const float* part, const float* b_ada, float* mods, LAS float* red, int tid, int bid, int G) {
    for (int ob = bid; ob < NMODV / 128; ob += G) {
        const int o = tid & 127, pr = tid >> 7; float s = 0.f;
#pragma unroll 4
        for (int i = 0; i < 16; ++i) s += part[(size_t)(pr * 16 + i) * NMODV + ob * 128 + o];
        red[pr * 128 + o] = s; __syncthreads();
        if (tid < 128) { const int j = ob * 128 + tid; float t = (red[tid] + red[128 + tid]) + (red[256 + tid] + red[384 + tid]); t += b_ada[j < 6 * DM ? j : j - 6 * DM]; mods[j] = t; }
        __syncthreads();
    }
}
__device__ __forceinline__ void ph_prenorm(const float* x, const float* ctx, const float* g, const float* mods, bf16* H, int gw, int NGW, int lane) {
    for (int m = gw; m < MROWS; m += NGW) {
        asm volatile("" ::: "memory");
        const bool lat = m < SEQ;
        const GAS f32x4* src = (const GAS f32x4*)(lat ? x + (size_t)m * DM : ctx + (size_t)(m - SEQ) * DM) + lane;
        const f32x4* sh = (const f32x4*)(mods + (lat ? 0 : 6 * DM)) + lane; const f32x4* sc = (const f32x4*)(mods + (lat ? DM : 7 * DM)) + lane; const f32x4* gg = (const f32x4*)g + lane;
        f32x4 v[16]; float ss = 0.f;
#pragma unroll
        for (int j = 0; j < 16; ++j) { v[j] = src[64 * j]; ss += dot4(v[j]); }
        const float rstd = rsqrtf(wave_sum(ss) * (1.0f / DM) + EPSN);
        GAS u32x2v* o8 = (GAS u32x2v*)(H + (size_t)m * DM) + lane;
#pragma unroll
        for (int j = 0; j < 16; ++j) { const f32x4 a = v[j] * rstd * gg[64 * j] * (sc[64 * j] + 1.0f) + sh[64 * j]; u32x2v w; w.x = pk2(a.x, a.y); w.y = pk2(a.z, a.w); o8[64 * j] = w; }
    }
}
__device__ __forceinline__ void ph_qk(const bf16* Z, const float* g_q, const float* g_k, const float* rope, bf16* Qn, bf16* Kn, bf16* Vn, float* lnst, int gw, int NGW, int lane) {
    const int fi = 2 * (lane & 15);
    const f32x2v gq = *(const f32x2v*)(g_q + 2 * lane), gk = *(const f32x2v*)(g_k + 2 * lane);
    for (int m = gw; m < MROWS; m += NGW) {
        const bf16* zr = Z + (size_t)m * INC; const bool lat = m < SEQ;
        const int pos = (lane < 32) ? (m >> 6) : (m & 63);
        f32x2v cs = (f32x2v){1.f, 1.f}, sn = (f32x2v){0.f, 0.f};
        if (lat) { cs = *(const f32x2v*)(rope + pos * 32 + fi); sn = *(const f32x2v*)(rope + 4096 + pos * 32 + fi); }
        const float sgn = (lane & 16) ? 1.0f : -1.0f;
        if (lat) {
#pragma unroll 4
            for (int h = 0; h < NHQ; ++h) {
                const unsigned w = *(const unsigned*)(zr + ZQ0 + h * HD + 2 * lane); float a = bflo(w), b = bfhi(w);
                const float rstd = rsqrtf(wave_sum(a * a + b * b) * (1.0f / HD) + EPSN); a *= rstd * gq.x; b *= rstd * gq.y;
                const float oa = __shfl_xor(a, 16), ob = __shfl_xor(b, 16);
                *(unsigned*)(Qn + (size_t)m * BWID + h * HD + 2 * lane) = pk2(a * cs.x + sgn * oa * sn.x, b * cs.y + sgn * ob * sn.y);
            }
        }
#pragma unroll
        for (int h = 0; h < NKVH; ++h) {
            const unsigned w = *(const unsigned*)(zr + ZK0 + h * HD + 2 * lane); float a = bflo(w), b = bfhi(w);
            const float rstd = rsqrtf(wave_sum(a * a + b * b) * (1.0f / HD) + EPSN); a *= rstd * gk.x; b *= rstd * gk.y;
            const float oa = __shfl_xor(a, 16), ob = __shfl_xor(b, 16);
            *(unsigned*)(Kn + (size_t)m * KVW + h * HD + 2 * lane) = pk2(a * cs.x + sgn * oa * sn.x, b * cs.y + sgn * ob * sn.y);
        }
        *(v4u*)(Vn + (size_t)m * KVW + 8 * lane) = *(const v4u*)(zr + ZV0 + 8 * lane);
        if (lat) {
            float gv[32]; float s = 0.f;
#pragma unroll
            for (int j = 0; j < 4; ++j) { const v4u w = *(const v4u*)(zr + AW + 8 * lane + 512 * j);
                gv[8 * j + 0] = gelu_erf(bflo(w.x)); gv[8 * j + 1] = gelu_erf(bfhi(w.x)); gv[8 * j + 2] = gelu_erf(bflo(w.y)); gv[8 * j + 3] = gelu_erf(bfhi(w.y));
                gv[8 * j + 4] = gelu_erf(bflo(w.z)); gv[8 * j + 5] = gelu_erf(bfhi(w.z)); gv[8 * j + 6] = gelu_erf(bflo(w.w)); gv[8 * j + 7] = gelu_erf(bfhi(w.w)); }
#pragma unroll
            for (int i = 0; i < 32; ++i) s += gv[i];
            const float mean = wave_sum(s) * (1.0f / AW); float q = 0.f;
#pragma unroll
            for (int i = 0; i < 32; ++i) { const float d = gv[i] - mean; q += d * d; }
            const float rstd = rsqrtf(wave_sum(q) * (1.0f / AW) + EPSN);
            if (lane == 0) *(f32x2v*)(lnst + 2 * m) = (f32x2v){mean, rstd};
        }
    }
}
constexpr int CM_LD = 136;
__device__ __forceinline__ void ph_chunk_mlp(const bf16* Z, const float* lnst, const float* ln_g, const float* ln_b, const float* w_s, const float* b_s, bf16* MIX,
                                             LAS unsigned char* lds, int tid, int bid, int G) {
    LAS bf16* As = (LAS bf16*)lds; LAS bf16* Bs = As + 128 * CM_LD;
    const int lane = tid & 63, wid = tid >> 6, r32 = lane & 31, hi = lane >> 5, pb = wid & 3, ch = wid >> 2;
    for (int u = bid; u < 64 * 16; u += G) {
        const int n = u >> 4, g = u & 15;
#pragma unroll
        for (int i = 0; i < 8; ++i) { const int e = (i * 512 + tid) * 4, p = e >> 7, q = e & 127; const f32x4 w = *(const f32x4*)(w_s + (size_t)g * 16384 + e);
            u32x2v o; o.x = pk2(w.x, w.y); o.y = pk2(w.z, w.w); *(LAS u32x2v*)(As + p * CM_LD + q) = o; }
#pragma unroll
        for (int i = 0; i < 4; ++i) { const int e = i * 512 + tid, q = e >> 4, c8 = (e & 15) * 8; const int row = n * 128 + q;
            const v4u w = *(const v4u*)(Z + (size_t)row * INC + AW + g * 128 + c8); const f32x2v st = *(const f32x2v*)(lnst + 2 * row);
            const f32x4 g0 = *(const f32x4*)(ln_g + g * 128 + c8), g1 = *(const f32x4*)(ln_g + g * 128 + c8 + 4), b0 = *(const f32x4*)(ln_b + g * 128 + c8), b1 = *(const f32x4*)(ln_b + g * 128 + c8 + 4);
            float v[8] = {bflo(w.x), bfhi(w.x), bflo(w.y), bfhi(w.y), bflo(w.z), bfhi(w.z), bflo(w.w), bfhi(w.w)};
            const float gm[8] = {g0.x, g0.y, g0.z, g0.w, g1.x, g1.y, g1.z, g1.w}, bt[8] = {b0.x, b0.y, b0.z, b0.w, b1.x, b1.y, b1.z, b1.w};
#pragma unroll
            for (int k = 0; k < 8; ++k) { const float y = (gelu_erf(v[k]) - st.x) * st.y * gm[k] + bt[k]; Bs[(c8 + k) * CM_LD + q] = (bf16)f2bf(y); } }
        __syncthreads();
        f32x16 acc0 = {}, acc1 = {};
#pragma unroll
        for (int ks = 0; ks < 8; ++ks) {
            const bf16x8 a = *(const LAS bf16x8*)(As + (32 * pb + r32) * CM_LD + ks * 16 + hi * 8);
            const bf16x8 b0 = *(const LAS bf16x8*)(Bs + (64 * ch + r32) * CM_LD + ks * 16 + hi * 8);
            const bf16x8 b1 = *(const LAS bf16x8*)(Bs + (64 * ch + 32 + r32) * CM_LD + ks * 16 + hi * 8);
            acc0 = __builtin_amdgcn_mfma_f32_32x32x16_bf16(a, b0, acc0, 0, 0, 0);
            acc1 = __builtin_amdgcn_mfma_f32_32x32x16_bf16(a, b1, acc1, 0, 0, 0);
        }
#pragma unroll
        for (int r = 0; r < 16; ++r) { const int p = 32 * pb + (r & 3) + 8 * (r >> 2) + 4 * hi; const int row = n * 128 + p; const float bs = b_s[g * 128 + p];
            const int c0 = g * 128 + 64 * ch + r32;
            const float u0 = gelu_erf(bf2f(Z[(size_t)row * INC + c0])), u1 = gelu_erf(bf2f(Z[(size_t)row * INC + c0 + 32]));
            MIX[(size_t)row * DM + c0] = (bf16)f2bf(u0 * (acc0[r] + bs)); MIX[(size_t)row * DM + c0 + 32] = (bf16)f2bf(u1 * (acc1[r] + bs)); }
        __syncthreads();
    }
}
__device__ __forceinline__ void ph_mixnorm(bf16* MIX, const float* g_a, const float* g_b, int gw, int NGW, int lane) {
    for (int m = gw; m < SEQ; m += NGW) {
        asm volatile("" ::: "memory");
        GAS v4u* rp = (GAS v4u*)(MIX + (size_t)m * DM) + lane; v4u w[8]; float sa = 0.f, sb = 0.f;
#pragma unroll
        for (int j = 0; j < 8; ++j) { w[j] = rp[64 * j]; const float t = (bflo(w[j].x) * bflo(w[j].x) + bfhi(w[j].x) * bfhi(w[j].x)) + (bflo(w[j].y) * bflo(w[j].y) + bfhi(w[j].y) * bfhi(w[j].y))
                + (bflo(w[j].z) * bflo(w[j].z) + bfhi(w[j].z) * bfhi(w[j].z)) + (bflo(w[j].w) * bflo(w[j].w) + bfhi(w[j].w) * bfhi(w[j].w)); if (j < 4) sa += t; else sb += t; }
        const float ra = rsqrtf(wave_sum(sa) * (1.0f / AW) + EPSN), rb = rsqrtf(wave_sum(sb) * (1.0f / BWID) + EPSN);
#pragma unroll
        for (int j = 0; j < 8; ++j) { const float r = j < 4 ? ra : rb; const float* gp = (j < 4 ? g_a + 512 * j : g_b + 512 * (j - 4)) + 8 * lane;
            const f32x4 g0 = *(const f32x4*)gp, g1 = *(const f32x4*)(gp + 4); v4u o;
            o.x = pk2(bflo(w[j].x) * r * g0.x, bfhi(w[j].x) * r * g0.y); o.y = pk2(bflo(w[j].y) * r * g0.z, bfhi(w[j].y) * r * g0.w);
            o.z = pk2(bflo(w[j].z) * r * g1.x, bfhi(w[j].z) * r * g1.y); o.w = pk2(bflo(w[j].w) * r * g1.z, bfhi(w[j].w) * r * g1.w); rp[64 * j] = o; }
    }
}
__device__ __forceinline__ void ph_postmix(const bf16* O, const float* x, const float* g_post, const float* g_pre2, const float* mods, float* out, bf16* H, LAS float* cl, int tid, int gw, int NGW, int lane) {
    for (int k = tid; k < DM; k += NWAVES * 64) { cl[k] = mods[2 * DM + k] * g_post[k]; cl[DM + k] = g_pre2[k] * (1.0f + mods[4 * DM + k]); cl[2 * DM + k] = mods[3 * DM + k]; }
    __syncthreads();
    const LAS f32x4* cA = (const LAS f32x4*)cl + lane; const LAS f32x4* cB = (const LAS f32x4*)(cl + DM) + lane; const LAS f32x4* cC = (const LAS f32x4*)(cl + 2 * DM) + lane;
    for (int m = gw; m < SEQ; m += NGW) {
        asm volatile("" ::: "memory");
        const GAS u32x2v* op = (const GAS u32x2v*)(O + (size_t)m * DM) + lane; const GAS f32x4* xp = (const GAS f32x4*)(x + (size_t)m * DM) + lane;
        f32x4 v[16]; float ss = 0.f;
#pragma unroll
        for (int j = 0; j < 16; ++j) { const u32x2v w = op[64 * j]; v[j] = (f32x4){bflo(w.x), bfhi(w.x), bflo(w.y), bfhi(w.y)}; ss += dot4(v[j]); }
        const float rstd = rsqrtf(wave_sum(ss) * (1.0f / DM) + EPSN); float s2 = 0.f;
        asm volatile("" ::: "memory");
        GAS f32x4* outp = (GAS f32x4*)(out + (size_t)m * DM) + lane;
#pragma unroll
        for (int j = 0; j < 16; ++j) { v[j] = xp[64 * j] + cA[64 * j] * (v[j] * rstd); s2 += dot4(v[j]); outp[64 * j] = v[j]; }
        const float rstd2 = rsqrtf(wave_sum(s2) * (1.0f / DM) + EPSN);
        asm volatile("" ::: "memory");
        GAS u32x2v* o8 = (GAS u32x2v*)(H + (size_t)m * DM) + lane;
#pragma unroll
        for (int j = 0; j < 16; ++j) { const f32x4 a = v[j] * rstd2 * cB[64 * j] + cC[64 * j]; u32x2v w; w.x = pk2(a.x, a.y); w.y = pk2(a.z, a.w); o8[64 * j] = w; }
    }
    __syncthreads();
}
__device__ __forceinline__ void ph_conv(const bf16* UP, const float* cw, const float* cb, bf16* Gb, int gtid, int NT) {
    constexpr int RB = 16, NCG = (DFF / 128) * 16, NIT = (SEQ / RB) * NCG;
    for (int it = gtid; it < NIT; it += NT) {
        const int cg = it % NCG, rr = it / NCG, T = cg >> 4, c8 = (cg & 15) * 8, r0 = rr * RB;
        const int f0 = T * 128 + c8;
        const size_t colg = (size_t)T * 256 + c8, colu = colg + 128;
        float wg[3][8], wu[3][8], bg[8], bu[8];
#pragma unroll
        for (int j = 0; j < 3; ++j) { const f32x4 a0 = *(const f32x4*)(cw + (size_t)j * UPC + f0), a1 = *(const f32x4*)(cw + (size_t)j * UPC + f0 + 4), b0 = *(const f32x4*)(cw + (size_t)j * UPC + DFF + f0), b1 = *(const f32x4*)(cw + (size_t)j * UPC + DFF + f0 + 4);
            wg[j][0] = a0.x; wg[j][1] = a0.y; wg[j][2] = a0.z; wg[j][3] = a0.w; wg[j][4] = a1.x; wg[j][5] = a1.y; wg[j][6] = a1.z; wg[j][7] = a1.w;
            wu[j][0] = b0.x; wu[j][1] = b0.y; wu[j][2] = b0.z; wu[j][3] = b0.w; wu[j][4] = b1.x; wu[j][5] = b1.y; wu[j][6] = b1.z; wu[j][7] = b1.w; }
        { const f32x4 a0 = *(const f32x4*)(cb + f0), a1 = *(const f32x4*)(cb + f0 + 4), b0 = *(const f32x4*)(cb + DFF + f0), b1 = *(const f32x4*)(cb + DFF + f0 + 4);
            bg[0] = a0.x; bg[1] = a0.y; bg[2] = a0.z; bg[3] = a0.w; bg[4] = a1.x; bg[5] = a1.y; bg[6] = a1.z; bg[7] = a1.w;
            bu[0] = b0.x; bu[1] = b0.y; bu[2] = b0.z; bu[3] = b0.w; bu[4] = b1.x; bu[5] = b1.y; bu[6] = b1.z; bu[7] = b1.w; }
        v4u pg, pu, cg4, cu4, ng, nu; const v4u zero = (v4u){0u, 0u, 0u, 0u};
        pg = r0 > 0 ? *(const v4u*)(UP + (size_t)(r0 - 1) * UPC + colg) : zero; pu = r0 > 0 ? *(const v4u*)(UP + (size_t)(r0 - 1) * UPC + colu) : zero;
        cg4 = *(const v4u*)(UP + (size_t)r0 * UPC + colg); cu4 = *(const v4u*)(UP + (size_t)r0 * UPC + colu);
#pragma unroll 4
        for (int r = r0; r < r0 + RB; ++r) {
            ng = (r + 1 < SEQ) ? *(const v4u*)(UP + (size_t)(r + 1) * UPC + colg) : zero; nu = (r + 1 < SEQ) ? *(const v4u*)(UP + (size_t)(r + 1) * UPC + colu) : zero;
            float o[8];
#define CV(k, W, HL) { const float ag = wg[0][k] * HL(pg.W) + wg[1][k] * HL(cg4.W) + wg[2][k] * HL(ng.W) + bg[k]; const float au = wu[0][k] * HL(pu.W) + wu[1][k] * HL(cu4.W) + wu[2][k] * HL(nu.W) + bu[k]; o[k] = silu_f(ag) * au; }
            CV(0, x, bflo) CV(1, x, bfhi) CV(2, y, bflo) CV(3, y, bfhi) CV(4, z, bflo) CV(5, z, bfhi) CV(6, w, bflo) CV(7, w, bfhi)
#undef CV
            v4u ov; ov.x = pk2(o[0], o[1]); ov.y = pk2(o[2], o[3]); ov.z = pk2(o[4], o[5]); ov.w = pk2(o[6], o[7]);
            *(v4u*)(Gb + (size_t)r * DFF + f0) = ov;
            pg = cg4; pu = cu4; cg4 = ng; cu4 = nu;
        }
    }
}
__device__ __forceinline__ void ph_final(const bf16* Fm, const float* g_post, const float* mods, float* out, int gw, int NGW, int lane) {
    const f32x4* gtf = (const f32x4*)(mods + 5 * DM) + lane; const f32x4* gp = (const f32x4*)g_post + lane;
    for (int m = gw; m < SEQ; m += NGW) {
        asm volatile("" ::: "memory");
        const GAS u32x2v* fp = (const GAS u32x2v*)(Fm + (size_t)m * DM) + lane; GAS f32x4* outp = (GAS f32x4*)(out + (size_t)m * DM) + lane;
        f32x4 v[16]; float ss = 0.f;
#pragma unroll
        for (int j = 0; j < 16; ++j) { const u32x2v w = fp[64 * j]; v[j] = (f32x4){bflo(w.x), bfhi(w.x), bflo(w.y), bfhi(w.y)}; ss += dot4(v[j]); }
        const float rstd = rsqrtf(wave_sum(ss) * (1.0f / DM) + EPSN);
#pragma unroll
        for (int j = 0; j < 16; ++j) outp[64 * j] = outp[64 * j] + gtf[64 * j] * (v[j] * rstd * gp[64 * j]);
    }
}

constexpr int NPHASE = 14;
struct Args { const float* in[24]; float* out; unsigned char* ws; int ph_lo, ph_hi; };
__global__ void __launch_bounds__(NWAVES * 64, 2) skel_fwd(Args args) {
    extern __shared__ __attribute__((aligned(16))) unsigned char lds[];
    LAS unsigned char* ldsb = (LAS unsigned char*)lds;
    volatile LAS unsigned* MISC = (volatile LAS unsigned*)(ldsb + MISC_OFF);
    const int wave = __builtin_amdgcn_readfirstlane((int)(threadIdx.x >> 6)); __builtin_assume(wave >= 0 && wave < NWAVES);
#define lane (lane_id())
#define tid (wave * 64 + lane_id())
    const int G = gridDim.x, bid = blockIdx.x;
#define gw (bid * NWAVES + wave)
#define NGW (G * NWAVES)
    unsigned char* ws = args.ws;
    gu32* ctl = (gu32*)(ws + WS_CTL);
#define I_(k) (args.in[k])
#define Xin I_(0)
#define cvec I_(1)
#define ctx I_(2)
#define c_ctx I_(3)
#define w_ada I_(4)
#define b_ada I_(5)
#define g_pre_mix I_(6)
#define g_post_mix I_(7)
#define g_pre_ffn I_(8)
#define g_post_ffn I_(9)
#define w_in I_(10)
#define ln_v_g I_(11)
#define ln_v_b I_(12)
#define w_s I_(13)
#define b_s I_(14)
#define g_q I_(15)
#define g_k I_(16)
#define g_out_a I_(17)
#define g_out_b I_(18)
#define w_out I_(19)
#define w_up I_(20)
#define conv_w I_(21)
#define conv_b I_(22)
#define w_down I_(23)
#define out (args.out)
#define mods ((float*)(ws + WS_MODS))
#define rope ((float*)(ws + WS_ROPE))
#define lnst ((float*)(ws + WS_LNST))
#define part ((float*)(ws + WS_PART))
#define win_t ((bf16*)(ws + WS_WIN))
#define wout_t ((bf16*)(ws + WS_WOUT))
#define wup_t ((bf16*)(ws + WS_WUP))
#define wdn_t ((bf16*)(ws + WS_WDN))
#define Hb ((bf16*)(ws + WS_H))
#define Zb ((bf16*)(ws + WS_Z))
#define Qn ((bf16*)(ws + WS_Q))
#define Kn ((bf16*)(ws + WS_K))
#define Vn ((bf16*)(ws + WS_V))
#define MIX ((bf16*)(ws + WS_MIX))
#define Ob ((bf16*)(ws + WS_O))
#define UPb ((bf16*)(ws + WS_UP))
#define Gb ((bf16*)(ws + WS_G))
    for (int u = tid; u < (LDS_BYTES - LDSCTL_OFF) / 4; u += NWAVES * 64) ((LAS unsigned*)(ldsb + LDSCTL_OFF))[u] = 0u;
    __syncthreads();
    XcdBarrier bar; bar.bar = (unsigned*)(ctl + CW_BAR); bar.x = 0; bar.st = nullptr;
    if (MK_ONE_LAUNCH) bar = xcd_barrier_post((unsigned*)(ctl + CW_BAR), MISC + 8);
#define GRID_BAR() do { if (MK_ONE_LAUNCH) xcd_barrier(bar); } while (0)
    const int lo = args.ph_lo, hi = args.ph_hi;
#ifndef PH_MASK
#define PH_MASK 0xFFFFF
#endif
#define IN(k) (((PH_MASK >> (k)) & 1) && lo <= (k) && (k) < hi)
#define BOTH(k) (IN(k) && IN((k) + 1))

    if (IN(0)) {
        ph_gemv(cvec, c_ctx, w_ada, part, (LAS float*)(ldsb + RING_OFF), tid, bid, G);
        ph_rope_table(rope, tid, bid);
        ph_convert<0>(w_in, w_out, w_up, w_down, win_t, wout_t, wup_t, wdn_t, (LAS float*)(ldsb + RING_OFF + wave * 16384), gw, NGW, lane);
        if (BOTH(0)) GRID_BAR();
    }
    if (IN(1)) { ph_mods_reduce(part, b_ada, mods, (LAS float*)(ldsb + RING_OFF), tid, bid, G); if (BOTH(1)) GRID_BAR(); }
    if (IN(2)) { ph_prenorm(Xin, ctx, g_pre_mix, mods, Hb, gw, NGW, lane); if (BOTH(2)) GRID_BAR(); }
    if (IN(3)) {
        pg8::Gemm g{Hb, win_t, MROWS, INC, DM}; pg8::InOrder S; S.init(G, bid);
        pg8::EpiBf16<0> E{Zb, INC, nullptr, 0, 0, 1.f};
        pg8::gemm_phase<pg8::EpiBf16<0>, pg8::InOrder, PG8_ALIGN, PG8_SP2>(ldsb + RING_OFF, g, S, E, wave);
        { const int rem = (32 * 28 + 4) % G, nconv = rem ? G - rem : G;
          if (bid >= (rem ? rem : 0)) ph_convert<1>(w_in, w_out, w_up, w_down, win_t, wout_t, wup_t, wdn_t, (LAS float*)(ldsb + RING_OFF + wave * 16384), (bid - (rem ? rem : 0)) * NWAVES + wave, nconv * NWAVES, lane); }
        if (BOTH(3)) GRID_BAR();
    }
    if (IN(4)) { ph_qk(Zb, g_q, g_k, rope, Qn, Kn, Vn, lnst, gw, NGW, lane); if (BOTH(4)) GRID_BAR(); }
    if (IN(5)) { ph_chunk_mlp(Zb, lnst, ln_v_g, ln_v_b, w_s, b_s, MIX, ldsb + RING_OFF, tid, bid, G); if (BOTH(5)) GRID_BAR(); }
    if (IN(6)) {
        for (int u = bid; u < NHQ * (SEQ / 256); u += G) {
            const int h = u >> 5, qb = u & 31;
            attn::attn_dense_body<attn::bf16>(Qn + (size_t)qb * 256 * BWID + h * HD, Kn + (h >> 2) * HD, Vn + (h >> 2) * HD, MIX + (size_t)qb * 256 * DM + AW + h * HD, MROWS, (char*)lds + RING_OFF, wave);
            __syncthreads();
        }
        if (BOTH(6)) GRID_BAR();
    }
    if (IN(7)) { ph_mixnorm(MIX, g_out_a, g_out_b, gw, NGW, lane); if (BOTH(7)) GRID_BAR(); }
    if (IN(8)) {
        pg8::Gemm g{MIX, wout_t, SEQ, DM, DM}; pg8::StaticOrder S; S.init(SEQ, DM, G, bid);
        pg8::EpiBf16<0> E{Ob, DM, nullptr, 0, 0, 1.f};
        pg8::gemm_phase<pg8::EpiBf16<0>, pg8::StaticOrder, PG8_ALIGN, PG8_SP2>(ldsb + RING_OFF, g, S, E, wave);
        if (BOTH(8)) GRID_BAR();
    }
    if (IN(9)) { ph_postmix(Ob, Xin, g_post_mix, g_pre_ffn, mods, out, Hb, (LAS float*)(ldsb + RING_OFF), tid, gw, NGW, lane); if (BOTH(9)) GRID_BAR(); }
    if (IN(10)) {
        pg8::Gemm g{Hb, wup_t, SEQ, UPC, DM}; pg8::StaticOrder S; S.init(SEQ, UPC, G, bid);
        pg8::EpiBf16<0> E{UPb, UPC, nullptr, 0, 0, 1.f};
        pg8::gemm_phase<pg8::EpiBf16<0>, pg8::StaticOrder, PG8_ALIGN, PG8_SP2>(ldsb + RING_OFF, g, S, E, wave);
        { const int rem = ((SEQ / 256) * (UPC / 256)) % G, nconv = rem ? G - rem : G;
          if (bid >= (rem ? rem : 0)) ph_convert<2>(w_in, w_out, w_up, w_down, win_t, wout_t, wup_t, wdn_t, (LAS float*)(ldsb + RING_OFF + wave * 16384), (bid - (rem ? rem : 0)) * NWAVES + wave, nconv * NWAVES, lane); }
        if (BOTH(10)) GRID_BAR();
    }
    if (IN(11)) { ph_conv(UPb, conv_w, conv_b, Gb, bid * (NWAVES * 64) + tid, G * NWAVES * 64); if (BOTH(11)) GRID_BAR(); }
    if (IN(12)) {
        pg8::Gemm g{Gb, wdn_t, SEQ, DM, DFF}; pg8::StaticOrder S; S.init(SEQ, DM, G, bid);
        pg8::EpiBf16<0> E{Ob, DM, nullptr, 0, 0, 1.f};
        pg8::gemm_phase<pg8::EpiBf16<0>, pg8::StaticOrder, PG8_ALIGN, PG8_SP2>(ldsb + RING_OFF, g, S, E, wave);
        if (BOTH(12)) GRID_BAR();
    }
    if (IN(13)) { ph_final(Ob, g_post_ffn, mods, out, gw, NGW, lane); }
#undef IN
#undef BOTH
#undef GRID_BAR
#undef tid
#undef lane
#undef gw
#undef NGW
#undef Xin
#undef cvec
#undef ctx
#undef c_ctx
#undef w_ada
#undef b_ada
#undef g_pre_mix
#undef g_post_mix
#undef g_pre_ffn
#undef g_post_ffn
#undef w_in
#undef ln_v_g
#undef ln_v_b
#undef w_s
#undef b_s
#undef g_q
#undef g_k
#undef g_out_a
#undef g_out_b
#undef w_out
#undef w_up
#undef conv_w
#undef conv_b
#undef w_down
#undef out
#undef mods
#undef rope
#undef lnst
#undef part
#undef win_t
#undef wout_t
#undef wup_t
#undef wdn_t
#undef Hb
#undef Zb
#undef Qn
#undef Kn
#undef Vn
#undef MIX
#undef Ob
#undef UPb
#undef Gb
}

extern "C" void kernel_launch(void* const* d_in, const int* in_sizes, int n_in, void* d_out, int out_size, void* d_ws, size_t ws_size, hipStream_t stream) {
    static int grid = 0;
    if (grid == 0) {
        if (n_in != 24 || in_sizes[0] != SEQ * DM || out_size != SEQ * DM || ws_size < WS_END) { fprintf(stderr, "kernel_launch: unexpected shapes: n_in %d in0 %d out %d ws %zu (need %zu)\n", n_in, n_in > 0 ? in_sizes[0] : -1, out_size, ws_size, (size_t)WS_END); grid = -1; return; }
        int dev = 0, cus = 0, per_cu = 0;
        if (hipGetDevice(&dev) != hipSuccess || hipDeviceGetAttribute(&cus, hipDeviceAttributeMultiprocessorCount, dev) != hipSuccess) { grid = -1; return; }
        if (hipFuncSetAttribute((const void*)skel_fwd, hipFuncAttributeMaxDynamicSharedMemorySize, LDS_BYTES) != hipSuccess) { fprintf(stderr, "kernel_launch: hipFuncSetAttribute failed\n"); grid = -1; return; }
        if (hipOccupancyMaxActiveBlocksPerMultiprocessor(&per_cu, (const void*)skel_fwd, NWAVES * 64, LDS_BYTES) != hipSuccess || per_cu < 1) fprintf(stderr, "kernel_launch: occupancy query says %d\n", per_cu);
        (void)hipGetLastError();
        grid = cus;
    }
    if (grid < 0) return;
    if (hipMemsetAsync((char*)d_ws + WS_CTL, 0, CTL_ZERO_BYTES, stream) != hipSuccess) return;
    Args a{};
    for (int i = 0; i < 24; ++i) a.in[i] = (const float*)d_in[i];
    a.out = (float*)d_out; a.ws = (unsigned char*)d_ws;
#if MK_ONE_LAUNCH
    a.ph_lo = 0; a.ph_hi = NPHASE;
    hipLaunchKernelGGL(skel_fwd, dim3(grid), dim3(NWAVES * 64), LDS_BYTES, stream, a);
#else
    for (int ph = 0; ph < NPHASE; ++ph) { a.ph_lo = ph; a.ph_hi = ph + 1; hipLaunchKernelGGL(skel_fwd, dim3(grid), dim3(NWAVES * 64), LDS_BYTES, stream, a); }
#endif
    const hipError_t le = hipPeekAtLastError();
    if (le != hipSuccess) fprintf(stderr, "kernel_launch: launch failed: %s\n", hipGetErrorName(le));
}
```

```cpp
#include <hip/hip_runtime.h>
#include <cstdio>
#include <cstdint>
__device__ __forceinline__ int lane_id() { const int l = (int)__builtin_amdgcn_mbcnt_hi(~0u, __builtin_amdgcn_mbcnt_lo(~0u, 0u)); __builtin_assume(l >= 0 && l < 64); return l; }
namespace pg8 {
#define PG8_LAS __attribute__((address_space(3)))
typedef unsigned short bf16_t;
typedef short bf16x8 __attribute__((ext_vector_type(8)));
typedef float f32x4 __attribute__((ext_vector_type(4)));
typedef unsigned u32x4 __attribute__((ext_vector_type(4)));
constexpr int BM = 256, BK = 64, HALF = 128, HTB = HALF * BK * 2  , STAGE_BYTES = 8 * HTB, NXCD = 8, WGM = 8;

__host__ __device__ __forceinline__ int lds_byte(int r, int c) { const int st = (r >> 4) * 2 + (c >> 5), rr = r & 15, cc = c & 31, ob = rr * 64 + cc * 2; return st * 1024 + (ob ^ (((ob >> 9) & 1) << 5)); }
__host__ __device__ __forceinline__ void stage_rc(int b, int& R, int& C) { const int st = b / 1024, sb = b % 1024, swz = sb ^ (((sb >> 9) & 1) << 5); R = (st >> 1) * 16 + swz / 64; C = (st & 1) * 32 + (swz % 64) / 2; }
__host__ __device__ __forceinline__ int perm32(int rho) { const int n = rho >> 4, i = rho & 15; return 8 * (i >> 2) + 4 * n + (i & 3); }

struct Unit { int pm, pn; };
struct Gemm { const bf16_t* A; const bf16_t* Bt; int M, N, K; };

struct StaticOrder {
    int nM, nN, nwg, G, c;
    __host__ __device__ void init(int M, int N, int G_, int c_) { nM = M / BM; nN = N / BM; nwg = nM * nN; G = G_; c = c_; }
    __host__ __device__ bool next(int i, Unit& u) const {
        const long L = (long)i * G + c; if (L >= nwg) return false;
        int wgid = (int)L; { const int q = nwg / NXCD, r = nwg % NXCD, xcd = wgid % NXCD, off = wgid / NXCD; wgid = (xcd < r ? xcd * (q + 1) : r * (q + 1) + (xcd - r) * q) + off; }
        const int nig = WGM * nN, gid = wgid / nig, fm = gid * WGM, gsz = (nM - fm) < WGM ? (nM - fm) : WGM;
        u.pm = fm + ((wgid % nig) % gsz); u.pn = (wgid % nig) / gsz; return true;
    }
    __device__ __forceinline__ void a_ready(const Unit&) const {}
    __device__ __forceinline__ void done(const Unit&) const {}
};

struct InOrder : StaticOrder {
    __host__ __device__ void init(int G_, int c_) { StaticOrder::init(32 * BM, 28 * BM, G_, c_); }
    __host__ __device__ bool next(int i, Unit& u) const {
        const long L = (long)i * G + c; if (L >= nwg + 4) return false;
        if (L >= nwg) { u.pm = 32; u.pn = 24 + (int)(L - nwg); return true; }
        return StaticOrder::next(i, u);
    }
};
__device__ __forceinline__ unsigned cvt_pk_bf16(float lo, float hi) { unsigned r; asm volatile("v_cvt_pk_bf16_f32 %0, %1, %2" : "=v"(r) : "v"(lo), "v"(hi)); return r; }
typedef float f32x2 __attribute__((ext_vector_type(2)));
__device__ __forceinline__ f32x2 gelu_pk(f32x2 v) {
    const f32x2 av = __builtin_elementwise_abs(v), d = av * 0.2316418882f + 1.0f;
    f32x2 t; t.x = __builtin_amdgcn_rcpf(d.x); t.y = __builtin_amdgcn_rcpf(d.y);
    f32x2 q = t * 0.5307027145f + (-0.7265760135f); q = q * t + 0.7107068705f; q = q * t + (-0.142248368f); q = q * t + 0.127414796f; q = q * t;
    const f32x2 s = (v * v) * (-0.72134752044f);
    f32x2 e; e.x = __builtin_amdgcn_exp2f(s.x); e.y = __builtin_amdgcn_exp2f(s.y);
    const f32x2 m = v * (q * e), r = v - m;
    f32x2 o; o.x = v.x < 0.f ? m.x : r.x; o.y = v.y < 0.f ? m.y : r.y; return o;
}

template <int ACT  > struct EpiBf16 {
    static constexpr bool PERM = true, AFTER_DRAIN = false; static_assert(ACT == 0 || ACT == 1, "EpiBf16: ACT is 0 (none) or 1 (gelu_pk)");
    bf16_t* O; int ldc; const float* bias; int split_cols; size_t split_stride; float scale0;
    __device__ __forceinline__ void operator()(const f32x4 (&acc)[2][2][4][2], const Unit& u, int wr, int wc, int fr, int fq) const {
        const int row0 = u.pm * BM + wr * 64 + fr; int colt = u.pn * BM; bf16_t* base = O;
        float sc = 1.f; if (split_cols) { const int t = colt / split_cols; base += (size_t)t * split_stride; colt -= t * split_cols; if (t == 0) sc = scale0; }
        const int col0 = colt + wc * 32 + 8 * fq, bcol0 = u.pn * BM + wc * 32 + 8 * fq;
        f32x4 bv[2][2];
#pragma unroll
        for (int bj = 0; bj < 2; ++bj)
#pragma unroll
            for (int n = 0; n < 2; ++n) bv[bj][n] = bias ? *(const f32x4*)(bias + bcol0 + bj * HALF + 4 * n) : (f32x4){0.f, 0.f, 0.f, 0.f};
#pragma unroll
        for (int ai = 0; ai < 2; ++ai)
#pragma unroll
            for (int m = 0; m < 4; ++m) { bf16_t* rowp = base + (size_t)(row0 + ai * HALF + m * 16) * ldc + col0;
#pragma unroll
                for (int bj = 0; bj < 2; ++bj) { f32x4 v0 = acc[ai][bj][m][0] + bv[bj][0], v1 = acc[ai][bj][m][1] + bv[bj][1];
                    if (ACT == 1) { f32x2 a = gelu_pk((f32x2){v0[0], v0[1]}), b = gelu_pk((f32x2){v0[2], v0[3]}), c = gelu_pk((f32x2){v1[0], v1[1]}), d = gelu_pk((f32x2){v1[2], v1[3]});
                        v0 = (f32x4){a.x, a.y, b.x, b.y}; v1 = (f32x4){c.x, c.y, d.x, d.y}; }
                    v0 = v0 * sc; v1 = v1 * sc; u32x4 w; w.x = cvt_pk_bf16(v0[0], v0[1]); w.y = cvt_pk_bf16(v0[2], v0[3]); w.z = cvt_pk_bf16(v1[0], v1[1]); w.w = cvt_pk_bf16(v1[2], v1[3]);
                    *(u32x4*)(rowp + bj * HALF) = w; } }
    }
};
struct EpiF32 {
    static constexpr bool PERM = false, AFTER_DRAIN = false;
    float* C; int ldc; const float* bias;
    __device__ __forceinline__ void operator()(const f32x4 (&acc)[2][2][4][2], const Unit& u, int wr, int wc, int fr, int fq) const {
        const int row0 = u.pm * BM + wr * 64 + fr, col0 = u.pn * BM + wc * 32 + 4 * fq;
        f32x4 bv[2][2];
#pragma unroll
        for (int bj = 0; bj < 2; ++bj)
#pragma unroll
            for (int n = 0; n < 2; ++n) bv[bj][n] = bias ? *(const f32x4*)(bias + col0 + bj * HALF + n * 16) : (f32x4){0.f, 0.f, 0.f, 0.f};
#pragma unroll
        for (int ai = 0; ai < 2; ++ai)
#pragma unroll
            for (int m = 0; m < 4; ++m) { float* rowp = C + (size_t)(row0 + ai * HALF + m * 16) * ldc + col0;
#pragma unroll
                for (int bj = 0; bj < 2; ++bj)
#pragma unroll
                    for (int n = 0; n < 2; ++n) *(f32x4*)(rowp + bj * HALF + n * 16) = acc[ai][bj][m][n] + bv[bj][n]; }
    }
};

template <int CTRL> __device__ __forceinline__ float dpp1(float v) { return __int_as_float(__builtin_amdgcn_update_dpp(0, __float_as_int(v), CTRL, 0xF, 0xF, false)); }
template <int CTRL> __device__ __forceinline__ f32x4 dpp4(f32x4 v) { f32x4 r; r.x = dpp1<CTRL>(v.x); r.y = dpp1<CTRL>(v.y); r.z = dpp1<CTRL>(v.z); r.w = dpp1<CTRL>(v.w); return r; }
__device__ __forceinline__ float silu_fast(float v) { return v * __builtin_amdgcn_rcpf(1.0f + __expf(-v)); }
struct EpiConvGate {
    static constexpr bool PERM = true, AFTER_DRAIN = false;
    bf16_t* Gm; int ldg; int nff; const float* cw; const float* cb; float* haloP; float* haloR;
    __device__ __forceinline__ void operator()(const f32x4 (&acc)[2][2][4][2], const Unit& u, int wr, int wc, int fr, int fq) const {
        const int jc = wc * 32 + 8 * fq, f0 = u.pn * 128 + jc, ldw = 2 * nff;
        f32x4 w[2][3][2], b[2][2];
#pragma unroll
        for (int bj = 0; bj < 2; ++bj)
#pragma unroll
            for (int n = 0; n < 2; ++n) { b[bj][n] = *(const f32x4*)(cb + bj * nff + f0 + 4 * n);
#pragma unroll
                for (int t = 0; t < 3; ++t) w[bj][t][n] = *(const f32x4*)(cw + (size_t)t * ldw + bj * nff + f0 + 4 * n); }
        const f32x4 z4 = (f32x4){0.f, 0.f, 0.f, 0.f};
#pragma unroll
        for (int ai = 0; ai < 2; ++ai) {
            const int row_s = u.pm * BM + ai * HALF + wr * 64, seg = row_s >> 6;
#pragma unroll
            for (int m = 0; m < 4; ++m) {
                f32x4 a[2][2];
#pragma unroll
                for (int bj = 0; bj < 2; ++bj)
#pragma unroll
                    for (int n = 0; n < 2; ++n) {
                        const f32x4 cur = acc[ai][bj][m][n];
                        const f32x4 ps = dpp4<0x121>(cur), pw = (m > 0) ? dpp4<0x121>(acc[ai][bj][m > 0 ? m - 1 : 0][n]) : z4;
                        const f32x4 ns = dpp4<0x12F>(cur), nw = (m < 3) ? dpp4<0x12F>(acc[ai][bj][m < 3 ? m + 1 : 3][n]) : z4;
                        const f32x4 prev = (fr == 0) ? pw : ps, next = (fr == 15) ? nw : ns;
                        a[bj][n] = w[bj][0][n] * prev + w[bj][1][n] * cur + w[bj][2][n] * next + b[bj][n];
                    }
                if ((m == 0 && fr == 0) || (m == 3 && fr == 15)) {
                    const size_t hb = (size_t)(seg * 2 + (m == 0 ? 0 : 1)) * ldw + (size_t)u.pn * 256 + jc;
#pragma unroll
                    for (int bj = 0; bj < 2; ++bj)
#pragma unroll
                        for (int n = 0; n < 2; ++n) { *(f32x4*)(haloP + hb + bj * 128 + 4 * n) = a[bj][n]; *(f32x4*)(haloR + hb + bj * 128 + 4 * n) = acc[ai][bj][m][n]; }
                }
                u32x4 o;
                o.x = cvt_pk_bf16(silu_fast(a[0][0].x) * a[1][0].x, silu_fast(a[0][0].y) * a[1][0].y); o.y = cvt_pk_bf16(silu_fast(a[0][0].z) * a[1][0].z, silu_fast(a[0][0].w) * a[1][0].w);
                o.z = cvt_pk_bf16(silu_fast(a[0][1].x) * a[1][1].x, silu_fast(a[0][1].y) * a[1][1].y); o.w = cvt_pk_bf16(silu_fast(a[0][1].z) * a[1][1].z, silu_fast(a[0][1].w) * a[1][1].w);
                *(u32x4*)(Gm + (size_t)(row_s + m * 16 + fr) * ldg + f0) = o;
            }
        }
    }
};

template <class Epi, class Sched, bool ALIGN_EPI = false, bool SP2 = false>
__device__ __forceinline__ void gemm_phase(PG8_LAS unsigned char* lds, const Gemm g, const Sched& S, const Epi& E, const int wave_) {
    const int lane = lane_id(), wid = wave_; __builtin_assume(lane >= 0 && lane < 64); __builtin_assume(wid >= 0 && wid < 8);
  const int tid = wid * 64 + lane, wr = wid >> 2, wc = wid & 3, fr = lane & 15, fq = lane >> 4;
    const int K = g.K, nt = K / BK;
    unsigned voffA[2], voffB[2];
#pragma unroll
    for (int i = 0; i < 2; ++i) { int R, C; stage_rc(tid * 16 + i * 8192, R, C); const int Rb = Epi::PERM ? ((R & ~31) + perm32(R & 31)) : R;
        voffA[i] = (unsigned)(R * K + C) * 2u; voffB[i] = (unsigned)(Rb * K + C) * 2u; }
    const size_t kstep = (size_t)(BK * 2);
    const size_t hstep = (size_t)HALF * K * 2;
    const size_t tstep = 2 * hstep;
    const unsigned ldsw = (unsigned)wid * 1024u;
    const int aoff = lds_byte(wr * 64 + fr, fq * 8), boff = lds_byte(wc * 32 + fr, fq * 8);
#define PG8_SA(b, h) (((b) * 2 + (h)) * HTB)
#define PG8_SB(b, h) ((4 + (b) * 2 + (h)) * HTB)
#define PG8_STAGE(bufoff, gbase, voff) do { _Pragma("unroll") for (int _i = 0; _i < 2; ++_i) \
        __builtin_amdgcn_global_load_lds((const unsigned*)((const char*)(gbase) + (voff)[_i]), (PG8_LAS unsigned*)(lds + (bufoff) + ldsw + _i * 8192), 16, 0, 0); } while (0)
#define PG8_LDA(dst, b, h) do { _Pragma("unroll") for (int m = 0; m < 4; ++m) _Pragma("unroll") for (int k = 0; k < 2; ++k) dst[m][k] = *(const PG8_LAS bf16x8*)(lds + PG8_SA(b, h) + aoff + m * 2048 + k * 1024); } while (0)
#define PG8_LDB(dst, b, h) do { _Pragma("unroll") for (int n = 0; n < 2; ++n) _Pragma("unroll") for (int k = 0; k < 2; ++k) dst[n][k] = *(const PG8_LAS bf16x8*)(lds + PG8_SB(b, h) + boff + n * 2048 + k * 1024); } while (0)
#define PG8_MMA(ai, bj, At, Bt) do { __builtin_amdgcn_s_setprio(1); _Pragma("unroll") for (int m = 0; m < 4; ++m) _Pragma("unroll") for (int n = 0; n < 2; ++n) _Pragma("unroll") for (int k = 0; k < 2; ++k) \
        acc[ai][bj][m][n] = __builtin_amdgcn_mfma_f32_16x16x32_bf16(Bt[n][k], At[m][k], acc[ai][bj][m][n], 0, 0, 0); __builtin_amdgcn_s_setprio(0); } while (0)
#define PG8_WAIT_V(n) asm volatile("s_waitcnt vmcnt(" #n ")" ::: "memory")
#define PG8_WAIT_L(n) asm volatile("s_waitcnt lgkmcnt(" #n ")" ::: "memory")
#define PG8_BAR __builtin_amdgcn_s_barrier()
#define PG8_SCHED __builtin_amdgcn_sched_barrier(0)
    Unit cur, nxt; int ui = 0;
    if (!S.next(0, cur)) return;
    f32x4 acc[2][2][4][2];
#pragma unroll
    for (int a = 0; a < 2; ++a)
#pragma unroll
        for (int b = 0; b < 2; ++b)
#pragma unroll
            for (int m = 0; m < 4; ++m)
#pragma unroll
                for (int n = 0; n < 2; ++n) acc[a][b][m][n] = (f32x4){0.f, 0.f, 0.f, 0.f};
    bf16x8 At[4][2], B0[2][2], B1[2][2];
    const char* cA = (const char*)g.A + (size_t)cur.pm * tstep; const char* cB = (const char*)g.Bt + (size_t)cur.pn * tstep;
    S.a_ready(cur);
    if constexpr (SP2) {
        PG8_STAGE(PG8_SB(0, 0), cB, voffB); PG8_STAGE(PG8_SB(0, 1), cB + hstep, voffB); PG8_STAGE(PG8_SA(0, 0), cA, voffA); PG8_STAGE(PG8_SA(0, 1), cA + hstep, voffA);
        if (wr == 1) PG8_BAR;
        PG8_WAIT_V(2); PG8_BAR;
        PG8_STAGE(PG8_SB(1, 0), cB + kstep, voffB); PG8_STAGE(PG8_SA(1, 0), cA + kstep, voffA); PG8_STAGE(PG8_SB(1, 1), cB + hstep + kstep, voffB);
        PG8_WAIT_V(6); PG8_BAR;
    } else {
        PG8_STAGE(PG8_SB(0, 0), cB, voffB); PG8_STAGE(PG8_SA(0, 0), cA, voffA); PG8_STAGE(PG8_SB(0, 1), cB + hstep, voffB); PG8_STAGE(PG8_SA(0, 1), cA + hstep, voffA);
        if (wr == 1) PG8_BAR;
        PG8_WAIT_V(4); PG8_BAR;
        PG8_STAGE(PG8_SB(1, 0), cB + kstep, voffB); PG8_STAGE(PG8_SA(1, 0), cA + kstep, voffA); PG8_STAGE(PG8_SB(1, 1), cB + hstep + kstep, voffB);
        PG8_WAIT_V(6); PG8_BAR;
    }
    for (;;) {
        const bool has_next = S.next(ui + 1, nxt);
        const char* nA = has_next ? (const char*)g.A + (size_t)nxt.pm * tstep : cA; const char* nB = has_next ? (const char*)g.Bt + (size_t)nxt.pn * tstep : cB;
        for (int t = 0; t < nt; t += 2) {
            const bool last = (t == nt - 2);
            const char* a1 = cA + (size_t)(t + 1) * kstep;
            const char* a2 = last ? nA : cA + (size_t)(t + 2) * kstep; const char* b2 = last ? nB : cB + (size_t)(t + 2) * kstep;
            const char* a3 = a2 + kstep; const char* b3 = b2 + kstep;
            if (last && has_next) S.a_ready(nxt);
            if constexpr (SP2) {
            PG8_LDB(B0, 0, 0); PG8_LDB(B1, 0, 1); PG8_SCHED; PG8_LDA(At, 0, 0); PG8_STAGE(PG8_SA(1, 1), a1 + hstep, voffA);
            PG8_WAIT_V(8); PG8_WAIT_L(0); PG8_BAR; PG8_MMA(0, 0, At, B0); PG8_MMA(0, 1, At, B1); PG8_BAR; PG8_SCHED;
            PG8_LDA(At, 0, 1); PG8_STAGE(PG8_SB(0, 0), b2, voffB); PG8_STAGE(PG8_SB(0, 1), b2 + hstep, voffB); PG8_STAGE(PG8_SA(0, 0), a2, voffA);
            PG8_WAIT_V(8); PG8_WAIT_L(0); PG8_BAR; PG8_MMA(1, 0, At, B0); PG8_MMA(1, 1, At, B1); PG8_BAR; PG8_SCHED;
            PG8_LDB(B0, 1, 0); PG8_LDB(B1, 1, 1); PG8_SCHED; PG8_LDA(At, 1, 0); PG8_STAGE(PG8_SA(0, 1), a2 + hstep, voffA);
            PG8_WAIT_V(8); PG8_WAIT_L(0); PG8_BAR; PG8_MMA(0, 0, At, B0); PG8_MMA(0, 1, At, B1); PG8_BAR; PG8_SCHED;
            PG8_LDA(At, 1, 1); PG8_STAGE(PG8_SB(1, 0), b3, voffB); PG8_STAGE(PG8_SB(1, 1), b3 + hstep, voffB); PG8_STAGE(PG8_SA(1, 0), a3, voffA);
            PG8_WAIT_V(8); PG8_WAIT_L(0); PG8_BAR; PG8_MMA(1, 0, At, B0); PG8_MMA(1, 1, At, B1); PG8_BAR; PG8_SCHED;
            } else {
            PG8_LDB(B0, 0, 0); PG8_SCHED; PG8_LDA(At, 0, 0); PG8_STAGE(PG8_SA(1, 1), a1 + hstep, voffA);
            PG8_WAIT_L(8); PG8_BAR; PG8_WAIT_L(0); PG8_MMA(0, 0, At, B0); PG8_BAR; PG8_SCHED;
            PG8_LDB(B1, 0, 1); PG8_STAGE(PG8_SB(0, 0), b2, voffB);
            PG8_BAR; PG8_WAIT_L(0); PG8_MMA(0, 1, At, B1); PG8_BAR;
            PG8_LDA(At, 0, 1); PG8_STAGE(PG8_SA(0, 0), a2, voffA);
            PG8_BAR; PG8_WAIT_L(0); PG8_MMA(1, 0, At, B0); PG8_BAR; PG8_SCHED;
            PG8_STAGE(PG8_SB(0, 1), b2 + hstep, voffB);
            PG8_WAIT_V(6); PG8_BAR; PG8_MMA(1, 1, At, B1); PG8_BAR;
            PG8_LDB(B0, 1, 0); PG8_SCHED; PG8_LDA(At, 1, 0); PG8_STAGE(PG8_SA(0, 1), a2 + hstep, voffA);
            PG8_WAIT_L(8); PG8_BAR; PG8_WAIT_L(0); PG8_MMA(0, 0, At, B0); PG8_BAR; PG8_SCHED;
            PG8_LDB(B1, 1, 1); PG8_STAGE(PG8_SB(1, 0), b3, voffB);
            PG8_BAR; PG8_WAIT_L(0); PG8_MMA(0, 1, At, B1); PG8_BAR;
            PG8_LDA(At, 1, 1); PG8_STAGE(PG8_SA(1, 0), a3, voffA);
            PG8_BAR; PG8_WAIT_L(0); PG8_MMA(1, 0, At, B0); PG8_BAR; PG8_SCHED;
            PG8_STAGE(PG8_SB(1, 1), b3 + hstep, voffB);
            PG8_WAIT_V(6); PG8_BAR; PG8_MMA(1, 1, At, B1); PG8_BAR;
            }
        }
        if constexpr (ALIGN_EPI) { if (wr == 0) PG8_BAR; }
        if constexpr (!Epi::AFTER_DRAIN) { E(acc, cur, wr, wc, fr, fq); S.done(cur); }
        if (!has_next) break;
#pragma unroll
        for (int a = 0; a < 2; ++a)
#pragma unroll
            for (int b = 0; b < 2; ++b)
#pragma unroll
                for (int m = 0; m < 4; ++m)
#pragma unroll
                    for (int n = 0; n < 2; ++n) acc[a][b][m][n] = (f32x4){0.f, 0.f, 0.f, 0.f};
        cur = nxt; cA = nA; cB = nB; ++ui;
        if constexpr (ALIGN_EPI) { if (wr == 1) PG8_BAR; }
    }
    PG8_WAIT_V(0);
    if constexpr (!ALIGN_EPI) { if (wr == 0) PG8_BAR; }
    PG8_BAR;
    if constexpr (Epi::AFTER_DRAIN) { E.fused(acc, cur, wr, wc, fr, fq, lds, wid, lane); S.done(cur); }
#undef PG8_SA
#undef PG8_SB
#undef PG8_STAGE
#undef PG8_LDA
#undef PG8_LDB
#undef PG8_MMA
#undef PG8_WAIT_V
#undef PG8_WAIT_L
#undef PG8_BAR
#undef PG8_SCHED
}
}

#ifndef PG8_SP2
#define PG8_SP2 true
#endif
#ifndef PG8_ALIGN
#define PG8_ALIGN true
#endif

namespace attn {
typedef unsigned short bf16;
constexpr int   D = 128, NW = 8, QBLK = 32, KVBLK = 64;
constexpr float SCALE = 0.088388347648318440f;
constexpr float THR = 8.f;
constexpr int SDEPTH = 2;
constexpr int LDQ = 2048, LDK = 512, LDO = 4096;
constexpr size_t SHM_V = KVBLK * D * 2, SHM_K = KVBLK * D * 2, SHM_ATTN = 2 * SHM_V + 2 * SHM_K + NW * 64 * 4;
using bf16x8 = __attribute__((ext_vector_type(8))) short;
using s16x4  = __attribute__((ext_vector_type(4))) short;
using f32x16 = __attribute__((ext_vector_type(16))) float;
using f32x8  = __attribute__((ext_vector_type(8))) float;
using u32x4  = __attribute__((ext_vector_type(4))) unsigned;
#define KSWZ(row, colB) ((row) * 256 + ((colB) ^ (((row) & 7) << 4)))
#define SBAR() __builtin_amdgcn_sched_barrier(0)
__device__ __forceinline__ int crow(int r, int hi) { return (r & 3) + 8 * (r >> 2) + 4 * hi; }
__device__ __forceinline__ unsigned cvtpk(float lo, float hi) {
  unsigned r; asm volatile("v_cvt_pk_bf16_f32 %0, %1, %2" : "=v"(r) : "v"(lo), "v"(hi)); return r;
}
__device__ __forceinline__ bf16 f2bf_rne(float f) { unsigned u = __builtin_bit_cast(unsigned, f); return (bf16)((u + 0x7fffu + ((u >> 16) & 1u)) >> 16); }
template <typename TIn> struct Stage;
template <> struct Stage<bf16>  { using T = bf16x8;
  __device__ static __forceinline__ T ld8(const bf16* p) { return *reinterpret_cast<const bf16x8*>(p); }
  __device__ static __forceinline__ bf16x8 tobf(T x) { return x; } };
template <> struct Stage<float> { using T = f32x8;
  __device__ static __forceinline__ T ld8(const float* p) { return *reinterpret_cast<const f32x8*>(p); }
  __device__ static __forceinline__ bf16x8 tobf(T x) {
    u32x4 w = {cvtpk(x[0], x[1]), cvtpk(x[2], x[3]), cvtpk(x[4], x[5]), cvtpk(x[6], x[7])}; return *reinterpret_cast<bf16x8*>(&w); } };

__device__ __forceinline__ void partialSM(f32x16& p0, f32x16& p1, float& m_reg, float& mn, float& alpha) {
  constexpr float C = SCALE * 1.4426950408889634f;
  float pmax = p0[0]; for (int r = 1; r < 16; ++r) pmax = fmaxf(pmax, p0[r]); for (int r = 0; r < 16; ++r) pmax = fmaxf(pmax, p1[r]);
  { auto rr = __builtin_amdgcn_permlane32_swap(__float_as_uint(pmax), __float_as_uint(pmax), false, false);
    pmax = fmaxf(__uint_as_float(rr[0]), __uint_as_float(rr[1])); }
  if (__builtin_expect(__all(pmax - m_reg <= THR / SCALE), 1)) { mn = m_reg; alpha = 1.f; }
  else { mn = fmaxf(m_reg, pmax); alpha = __builtin_amdgcn_exp2f((m_reg - mn) * C); m_reg = mn; }
  float mnC = -mn * C;
  for (int r = 0; r < 16; ++r) p0[r] = fmaf(p0[r], C, mnC); for (int r = 0; r < 16; ++r) p1[r] = fmaf(p1[r], C, mnC);
  for (int r = 0; r < 16; ++r) p0[r] = __builtin_amdgcn_exp2f(p0[r]);
}
__device__ __forceinline__ void finishSM(f32x16& p0, f32x16& p1, float alpha, float& l_reg, bf16x8& pa0, bf16x8& pa1, bf16x8& pa2, bf16x8& pa3) {
  for (int r = 0; r < 16; ++r) p1[r] = __builtin_amdgcn_exp2f(p1[r]);
  float ps = 0; for (int r = 0; r < 16; ++r) ps += p0[r]; for (int r = 0; r < 16; ++r) ps += p1[r];
  { auto rr = __builtin_amdgcn_permlane32_swap(__float_as_uint(ps), __float_as_uint(ps), false, false);
    ps = __uint_as_float(rr[0]) + __uint_as_float(rr[1]); }
  l_reg = l_reg * alpha + ps;
#define PK4(P, BASE, OUT) do { unsigned a0 = cvtpk(P[BASE + 0], P[BASE + 1]), a1 = cvtpk(P[BASE + 2], P[BASE + 3]);   \
    unsigned b0 = cvtpk(P[BASE + 4], P[BASE + 5]), b1 = cvtpk(P[BASE + 6], P[BASE + 7]);                              \
    auto r0 = __builtin_amdgcn_permlane32_swap(a0, b0, false, false); auto r1 = __builtin_amdgcn_permlane32_swap(a1, b1, false, false); \
    u32x4 w = {r0[0], r1[0], r0[1], r1[1]}; OUT = *reinterpret_cast<bf16x8*>(&w); } while (0)
  PK4(p0, 0, pa0); PK4(p0, 8, pa1); PK4(p1, 0, pa2); PK4(p1, 8, pa3);
#undef PK4
}
__device__ __forceinline__ void qkt(f32x16& p0, f32x16& p1, const bf16* Ks, const bf16x8* qr, int r32, int hi) {
  p0 = f32x16{}; p1 = f32x16{};
  for (int d0 = 0; d0 < 8; ++d0) { int cb = (d0 * 16 + hi * 8) * 2;
    bf16x8 b0 = *reinterpret_cast<const bf16x8*>((const char*)Ks + KSWZ(r32, cb));
    bf16x8 b1 = *reinterpret_cast<const bf16x8*>((const char*)Ks + KSWZ(32 + r32, cb));
    p0 = __builtin_amdgcn_mfma_f32_32x32x16_bf16(b0, qr[d0], p0, 0, 0, 0);
    p1 = __builtin_amdgcn_mfma_f32_32x32x16_bf16(b1, qr[d0], p1, 0, 0, 0); }
}
__device__ __forceinline__ int v_st(int k, int c) { const int kk = (k & ~0xC) | ((k & 4) << 1) | ((k & 8) >> 1); return ((kk >> 3) * 4 + (c >> 5)) * 512 + ((kk & 7) * 32 + (c & 31)) * 2; }
__device__ __forceinline__ int v_rd_base(int lane) { return ((lane & 3) << 3) | (((lane >> 2) & 3) << 6) | (((lane >> 4) & 1) << 5) | (((lane >> 5) & 1) << 8); }
constexpr int v_rd_off(int d0, int ks, int half) { return d0 * 512 + ks * 4096 + half * 2048; }
template <int OFF> __device__ __forceinline__ s16x4 tr_read(int vb) {
  s16x4 r; asm volatile("ds_read_b64_tr_b16 %0, %1 offset:%2" : "=&v"(r) : "v"(vb), "i"(OFF) : "memory"); return r;
}
template <int D0> __device__ __forceinline__ void pv_one(f32x16& od, int vb, bf16x8 pa0, bf16x8 pa1, bf16x8 pa2, bf16x8 pa3) {
  const s16x4 l0 = tr_read<v_rd_off(D0, 0, 0)>(vb), h0 = tr_read<v_rd_off(D0, 0, 1)>(vb), l1 = tr_read<v_rd_off(D0, 1, 0)>(vb), h1 = tr_read<v_rd_off(D0, 1, 1)>(vb);
  const s16x4 l2 = tr_read<v_rd_off(D0, 2, 0)>(vb), h2 = tr_read<v_rd_off(D0, 2, 1)>(vb), l3 = tr_read<v_rd_off(D0, 3, 0)>(vb), h3 = tr_read<v_rd_off(D0, 3, 1)>(vb);
  asm volatile("s_waitcnt lgkmcnt(0)" ::: "memory"); SBAR();
#define PK(L, H) (bf16x8){L[0], L[1], L[2], L[3], H[0], H[1], H[2], H[3]}
  od = __builtin_amdgcn_mfma_f32_32x32x16_bf16(pa0, PK(l0, h0), od, 0, 0, 0);
  od = __builtin_amdgcn_mfma_f32_32x32x16_bf16(pa1, PK(l1, h1), od, 0, 0, 0);
  od = __builtin_amdgcn_mfma_f32_32x32x16_bf16(pa2, PK(l2, h2), od, 0, 0, 0);
  od = __builtin_amdgcn_mfma_f32_32x32x16_bf16(pa3, PK(l3, h3), od, 0, 0, 0);
#undef PK
}
__device__ __forceinline__ void pv_d0(f32x16* o, int vb, bf16x8 pa0, bf16x8 pa1, bf16x8 pa2, bf16x8 pa3) {
  pv_one<0>(o[0], vb, pa0, pa1, pa2, pa3); pv_one<1>(o[1], vb, pa0, pa1, pa2, pa3); pv_one<2>(o[2], vb, pa0, pa1, pa2, pa3); pv_one<3>(o[3], vb, pa0, pa1, pa2, pa3);
}

template <typename TQ>
__device__ __forceinline__ void attn_dense_body(const TQ* __restrict__ Qb, const bf16* __restrict__ Kh, const bf16* __restrict__ Vh,
                                                bf16* __restrict__ Ob, int seq, char* lds, const int wave_) {
  using St = Stage<bf16>; using SQ = Stage<TQ>;
  const int lane = lane_id(), wid = wave_; __builtin_assume(lane >= 0 && lane < 64); __builtin_assume(wid >= 0 && wid < 8);
  const int tid = wid * 64 + lane, r32 = lane & 31, hi = lane >> 5;
  bf16* V_lds = (bf16*)lds; bf16* K_lds = (bf16*)(lds + 2 * SHM_V);
  float* ws = (float*)(lds + 2 * SHM_V + 2 * SHM_K) + wid * 64; float* li_l = ws; float* al_l = ws + 32;
  float m_reg = -1e30f, l_reg = 0; f32x16 o[4] = {}; bf16x8 qr[8];
  const TQ* Qw = Qb + (long)(wid * QBLK + r32) * LDQ + hi * 8;
#pragma unroll
  for (int d0 = 0; d0 < 8; ++d0) qr[d0] = SQ::tobf(SQ::ld8(Qw + d0 * 16));
  const int sr = tid >> 4, sc = (tid & 15) * 8, vst0 = v_st(sr, sc), vst1 = v_st(32 + sr, sc);
  const int vb0 = (int)(uintptr_t)V_lds + v_rd_base(lane);
  struct { typename St::T vs0, vs1, ks0, ks1; } sr_[SDEPTH];
#define SLOAD(i, k0) do { sr_[i].vs0 = St::ld8(&Vh[(long)((k0) + sr) * LDK + sc]); sr_[i].vs1 = St::ld8(&Vh[(long)((k0) + 32 + sr) * LDK + sc]); \
    sr_[i].ks0 = St::ld8(&Kh[(long)((k0) + sr) * LDK + sc]); sr_[i].ks1 = St::ld8(&Kh[(long)((k0) + 32 + sr) * LDK + sc]); } while (0)
#define SWRITE(b, i) do { *(bf16x8*)((char*)V_lds + (b) * SHM_V + vst0) = St::tobf(sr_[i].vs0);          \
    *(bf16x8*)((char*)V_lds + (b) * SHM_V + vst1) = St::tobf(sr_[i].vs1); int kc = sc * 2;               \
    *(bf16x8*)((char*)K_lds + (b) * SHM_K + KSWZ(sr, kc)) = St::tobf(sr_[i].ks0);                       \
    *(bf16x8*)((char*)K_lds + (b) * SHM_K + KSWZ(32 + sr, kc)) = St::tobf(sr_[i].ks1); } while (0)
#define SWAIT() do { if constexpr (SDEPTH == 2) asm volatile("s_waitcnt vmcnt(4)" ::: "memory"); else asm volatile("s_waitcnt vmcnt(0)" ::: "memory"); } while (0)
#define RESC(a) do { if (__any((a) < 1.f)) { if (hi == 0) al_l[r32] = (a); asm volatile("s_waitcnt lgkmcnt(0)" ::: "memory"); \
    for (int d = 0; d < 4; ++d) for (int r = 0; r < 16; ++r) o[d][r] *= al_l[crow(r, hi)]; } } while (0)
  f32x16 pA0, pA1, pB0, pB1; float mnA, mnB, alA, alB; bf16x8 pa0, pa1, pa2, pa3; const int NT = seq / KVBLK;
  constexpr int SE = 0, SO = SDEPTH - 1;
  SLOAD(SE, 0); asm volatile("s_waitcnt vmcnt(0)" ::: "memory"); SWRITE(0, SE); __syncthreads();
  qkt(pA0, pA1, K_lds, qr, r32, hi); partialSM(pA0, pA1, m_reg, mnA, alA);
  SLOAD(SO, KVBLK); if constexpr (SDEPTH == 2) { if (2 < NT) SLOAD(SE, 2 * KVBLK); }
  SWAIT(); SWRITE(1, SO); __syncthreads();
  for (int j = 1; j + 1 < NT; j += 2) {
    SBAR(); qkt(pB0, pB1, (bf16*)((char*)K_lds + SHM_K), qr, r32, hi);
    finishSM(pA0, pA1, alA, l_reg, pa0, pa1, pa2, pa3); SBAR();
    SLOAD(SO, (j + SDEPTH) * KVBLK); SBAR();
    pv_d0(o, vb0, pa0, pa1, pa2, pa3); partialSM(pB0, pB1, m_reg, mnB, alB);
    __syncthreads(); SWAIT(); SWRITE(0, SE);
    RESC(alB); __syncthreads();
    SBAR(); qkt(pA0, pA1, K_lds, qr, r32, hi);
    finishSM(pB0, pB1, alB, l_reg, pa0, pa1, pa2, pa3); SBAR();
    if (SDEPTH == 1 || j + 3 < NT) SLOAD(SE, (j + 1 + SDEPTH) * KVBLK); SBAR();
    pv_d0(o, vb0 + (int)SHM_V, pa0, pa1, pa2, pa3); partialSM(pA0, pA1, m_reg, mnA, alA);
    __syncthreads(); SWAIT(); SWRITE(1, SO);
    RESC(alA); __syncthreads();
  }
  SBAR(); qkt(pB0, pB1, (bf16*)((char*)K_lds + SHM_K), qr, r32, hi);
  finishSM(pA0, pA1, alA, l_reg, pa0, pa1, pa2, pa3); SBAR();
  pv_d0(o, vb0, pa0, pa1, pa2, pa3); partialSM(pB0, pB1, m_reg, mnB, alB);
  __syncthreads(); RESC(alB);
  finishSM(pB0, pB1, alB, l_reg, pa0, pa1, pa2, pa3); SBAR();
  pv_d0(o, vb0 + (int)SHM_V, pa0, pa1, pa2, pa3);
  if (hi == 0) li_l[r32] = l_reg; asm volatile("s_waitcnt lgkmcnt(0)" ::: "memory");
  float rli[16];
#pragma unroll
  for (int r = 0; r < 16; ++r) rli[r] = __builtin_amdgcn_rcpf(li_l[crow(r, hi)]);
  bf16* Ow = Ob + (long)(wid * QBLK) * LDO;
#pragma unroll
  for (int r = 0; r < 16; ++r) { int orow = crow(r, hi);
    for (int d0 = 0; d0 < 4; ++d0) Ow[(long)orow * LDO + d0 * 32 + r32] = f2bf_rne(o[d0][r] * rli[r]); }
#undef SLOAD
#undef SWRITE
#undef SWAIT
#undef RESC
}
}

constexpr int NWAVES = 8;
#ifndef MK_ONE_LAUNCH
#define MK_ONE_LAUNCH 1
#endif

constexpr int DM = 4096, SEQ = 8192, CTXN = 256, MROWS = SEQ + CTXN;
constexpr int AW = 2048, BWID = 2048, HD = 128, NHQ = 16, NKVH = 4, KVW = 512;
constexpr int INC = 7168, DFF = 11008, UPC = 2 * DFF;
constexpr int ZQ0 = 4096, ZK0 = 6144, ZV0 = 6656;
constexpr float EPSN = 1e-6f;
constexpr int NMODV = 32768;

constexpr size_t MiB = 1u << 20;
constexpr size_t WS_CTL = 0, CTL_ZERO_BYTES = 1 * MiB;
constexpr size_t WS_MODS = 1 * MiB;
constexpr size_t WS_ROPE = 1 * MiB + 256 * 1024;
constexpr size_t WS_LNST = 2 * MiB;
constexpr size_t WS_PART = 4 * MiB;
constexpr size_t WS_WIN = 16 * MiB, WS_WOUT = 72 * MiB, WS_WUP = 104 * MiB, WS_WDN = 276 * MiB;
constexpr size_t WS_H = 362 * MiB;
constexpr size_t WS_Z = 428 * MiB;
constexpr size_t WS_Q = 544 * MiB, WS_K = 576 * MiB, WS_V = 585 * MiB;
constexpr size_t WS_MIX = 594 * MiB;
constexpr size_t WS_O = 658 * MiB;
constexpr size_t WS_UP = 786 * MiB;
constexpr size_t WS_G = 1130 * MiB;
constexpr size_t WS_END = 1302 * MiB;
constexpr int CW_BAR = 4096;

constexpr int RING_OFF = 0, RING_BYTES = 131072;
constexpr int LDSCTL_OFF = RING_BYTES, MISC_OFF = LDSCTL_OFF + 320;
constexpr int LDS_BYTES = 147456;

#define GAS __attribute__((address_space(1)))
#define LAS __attribute__((address_space(3)))
typedef unsigned short bf16;
typedef unsigned v4u __attribute__((ext_vector_type(4)));
typedef float f32x4 __attribute__((ext_vector_type(4)));
typedef short bf16x8 __attribute__((ext_vector_type(8)));
typedef GAS unsigned gu32;
typedef GAS unsigned long long gu64;
#define RLX_AGENT __ATOMIC_RELAXED, __HIP_MEMORY_SCOPE_AGENT
#define LDS_WAIT() asm volatile("s_waitcnt lgkmcnt(0)" ::: "memory")
#define VM_WAIT() asm volatile("s_waitcnt vmcnt(0)" ::: "memory")
__device__ __forceinline__ unsigned long long rt() { return __builtin_amdgcn_s_memrealtime(); }
__device__ __forceinline__ unsigned f2bf(float f) { unsigned u = __builtin_bit_cast(unsigned, f); return (u + 0x7fffu + ((u >> 16) & 1u)) >> 16; }
__device__ __forceinline__ unsigned pk2(float lo, float hi) { return f2bf(lo) | (f2bf(hi) << 16); }

#define XB_TMO      128
#define XB_XCNT(j)  (256  + 64 * (j))
#define XB_XSUB(j)  (1280 + 64 * (j))
#define XB_XGEN(j)  (2304 + 64 * (j))
#define XB_TOP      3328
#define XB_TOPGEN   3392
#define XCD_BAR_WORDS 3456
#define XB_SPIN_CAP (1u << 18)

__device__ __forceinline__ unsigned xb_ld(unsigned* p)              { return __hip_atomic_load(p, __ATOMIC_RELAXED, __HIP_MEMORY_SCOPE_AGENT); }
__device__ __forceinline__ unsigned xb_add(unsigned* p, unsigned v) { return __hip_atomic_fetch_add(p, v, __ATOMIC_RELAXED, __HIP_MEMORY_SCOPE_AGENT); }
__device__ __forceinline__ unsigned xb_xcc_id() { return (unsigned)__builtin_amdgcn_s_getreg((3 << 11) | 20) & 0xFu; }
#define XB_SPIN(cond, bar) do { unsigned _sp = 0; while (cond) { __builtin_amdgcn_s_sleep(1); \
    if ((++_sp & 255u) == 0u) { if (xb_ld(&(bar)[XB_TMO])) break; if (_sp > XB_SPIN_CAP) { atomicAdd(&(bar)[XB_TMO], 1u); break; } } } } while (0)

struct XcdBarrier {
    unsigned* bar; unsigned x;
    volatile LAS unsigned* st;
};

__device__ __forceinline__ XcdBarrier xcd_barrier_post(unsigned* bar, volatile LAS unsigned* st) {
    XcdBarrier b; b.bar = bar; b.x = xb_xcc_id(); b.st = st;
    if (threadIdx.x == 0) (void)xb_add(&bar[XB_XCNT(b.x)], 1u);
    return b;
}
__device__ __forceinline__ void xcd_barrier_complete(unsigned* bar, unsigned x, unsigned& nloc, unsigned& nx) {
    const unsigned G = gridDim.x * gridDim.y * gridDim.z;
    unsigned sum, cnt, mine, sp = 0u;
    for (;;) {
        sum = 0u; cnt = 0u; mine = 0u;
#pragma unroll
        for (unsigned j = 0; j < 16; ++j) { const unsigned c = xb_ld(&bar[XB_XCNT(j)]); sum += c; cnt += (c > 0u) ? 1u : 0u; mine = (j == x) ? c : mine; }
        if (sum == G) break;
        __builtin_amdgcn_s_sleep(1);
        if ((++sp & 255u) == 0u) { if (xb_ld(&bar[XB_TMO])) break; if (sp > XB_SPIN_CAP) { atomicAdd(&bar[XB_TMO], 1u); break; } }
    }
    nloc = mine > 0u ? mine : 1u; nx = cnt > 0u ? cnt : 1u;
}

__device__ __forceinline__ void xcd_barrier(const XcdBarrier& b) {
    asm volatile("s_waitcnt vmcnt(0)" ::: "memory");
    __syncthreads();
    if (threadIdx.x == 0) {
        unsigned* bar = b.bar;
        __builtin_amdgcn_s_waitcnt(0);
        unsigned nloc = b.st[0], nx = b.st[1];
        if (nloc == 0u) { xcd_barrier_complete(bar, b.x, nloc, nx); b.st[0] = nloc; b.st[1] = nx; }
        const unsigned old = xb_add(&bar[XB_XSUB(b.x)], 1u);
        const unsigned gen = old / nloc;
        if (old + 1u == (gen + 1u) * nloc) {
            __builtin_amdgcn_fence(__ATOMIC_RELEASE, "agent");
            asm volatile("s_waitcnt vmcnt(0)" ::: "memory");
            const unsigned og = xb_add(&bar[XB_TOP], 1u);
            const unsigned tg = og / nx;
            if (og + 1u == (tg + 1u) * nx) xb_add(&bar[XB_TOPGEN], 1u);
            else XB_SPIN(xb_ld(&bar[XB_TOPGEN]) == tg, bar);
            __builtin_amdgcn_fence(__ATOMIC_ACQUIRE, "agent");
            xb_add(&bar[XB_XGEN(b.x)], 1u);
            asm volatile("s_waitcnt vmcnt(0)" ::: "memory");
        } else {
            XB_SPIN(xb_ld(&bar[XB_XGEN(b.x)]) == gen, bar);
            __builtin_amdgcn_fence(__ATOMIC_ACQUIRE, "agent");
            asm volatile("s_waitcnt vmcnt(0)" ::: "memory");
        }
    }
    __syncthreads();
}

typedef float f32x2v __attribute__((ext_vector_type(2)));
typedef unsigned u32x2v __attribute__((ext_vector_type(2)));
typedef float f32x16 __attribute__((ext_vector_type(16)));
__device__ __forceinline__ float wave_sum(float v) {
#pragma unroll
    for (int o = 1; o < 64; o <<= 1) v += __shfl_xor(v, o);
    return v;
}
__device__ __forceinline__ float bflo(unsigned w) { return __uint_as_float(w << 16); }
__device__ __forceinline__ float bfhi(unsigned w) { return __uint_as_float(w & 0xffff0000u); }
__device__ __forceinline__ float bf2f(bf16 b) { return __uint_as_float(((unsigned)b) << 16); }
__device__ __forceinline__ float gelu_erf(float v) { return 0.5f * v * (1.0f + erff(v * 0.70710678118654752f)); }
__device__ __forceinline__ float silu_f(float v) { return v / (1.0f + __expf(-v)); }
__device__ __forceinline__ float dot4(f32x4 a) { return (a.x * a.x + a.y * a.y) + (a.z * a.z + a.w * a.w); }

__device__ __forceinline__ void ph_gemv(const float* c, const float* cx, const float* w_ada, float* part, LAS float* sl, int tid, int bid, int G) {
    for (int k = tid; k < DM; k += NWAVES * 64) { const float a = c[k]; sl[k] = a / (1.0f + expf(-a)); const float b = cx[k]; sl[DM + k] = b / (1.0f + expf(-b)); }
    __syncthreads();
    const int half = tid >> 8, tx = tid & 255;
    for (int it = bid; it < 768; it += G) {
        const int jt = it % 24, ks = it / 24;
        const int j0 = jt * 1024 + tx * 4, kbase = ks * 128 + half * 64;
        const f32x4* wp = (const f32x4*)(w_ada + (size_t)kbase * (6 * DM) + j0);
        f32x4 ac = (f32x4){0.f, 0.f, 0.f, 0.f}, ax = (f32x4){0.f, 0.f, 0.f, 0.f};
#pragma unroll 8
        for (int i = 0; i < 64; ++i) { const f32x4 w = wp[(size_t)i * (6 * DM / 4)]; const float sc = sl[kbase + i], sx = sl[DM + kbase + i]; ac += w * sc; ax += w * sx; }
        float* po = part + (size_t)(ks * 2 + half) * NMODV;
        *(f32x4*)(po + j0) = ac;
        if (jt < 8) *(f32x4*)(po + 6 * DM + j0) = ax;
    }
    __syncthreads();
}
__device__ __forceinline__ void ph_rope_table(float* rope, int tid, int bid) {
    const int gid = bid * (NWAVES * 64) + tid;
    if (gid < 4096) { const int pos = gid >> 5, i = gid & 31; const float fr = powf(10000.0f, -(float)i / 32.0f); const float ang = (float)pos * fr; rope[gid] = cosf(ang); rope[4096 + gid] = sinf(ang); }
}
__device__ __forceinline__ void transpose_item(const float* W, int N, int k0, int n_src0, bf16* WT, int K, int n_dst0, LAS float* scr, int lane) {
#pragma unroll 8
    for (int i = 0; i < 32; ++i) { const int kk = 2 * i + (lane >> 5); scr[kk * 33 + (lane & 31)] = W[(size_t)(k0 + kk) * N + n_src0 + (lane & 31)]; }
    LDS_WAIT(); asm volatile("" ::: "memory");
    const int c = lane & 7;
#pragma unroll
    for (int j = 0; j < 4; ++j) { const int n = (lane >> 3) + 8 * j; const LAS float* s = scr + (8 * c) * 33 + n;
        v4u o; o.x = pk2(s[0 * 33], s[1 * 33]); o.y = pk2(s[2 * 33], s[3 * 33]); o.z = pk2(s[4 * 33], s[5 * 33]); o.w = pk2(s[6 * 33], s[7 * 33]);
        *(GAS v4u*)(WT + (size_t)(n_dst0 + n) * K + k0 + 8 * c) = o; }
    LDS_WAIT(); asm volatile("" ::: "memory");
}
template <int WHICH  >
__device__ __forceinline__ void ph_convert(const float* w_in, const float* w_out, const float* w_up, const float* w_dn, bf16* win_t, bf16* wout_t, bf16* wup_t, bf16* wdn_t,
                                           LAS float* scr, int gw, int NGW, int lane) {
    constexpr int I_IN = (DM / 64) * (INC / 32), I_OUT = (DM / 64) * (DM / 32), I_UP = (DM / 64) * (UPC / 32), I_DN = (DFF / 64) * (DM / 32);
    if constexpr (WHICH == 0) {
        for (int r = gw; r < I_IN; r += NGW) { const int nblk = INC / 32, kb = r / nblk, nb = r % nblk; transpose_item(w_in, INC, 64 * kb, 32 * nb, win_t, DM, 32 * nb, scr, lane); }
    } else if constexpr (WHICH == 1) {
        for (int it = gw; it < I_OUT + I_UP; it += NGW) {
            int r = it;
            if (r < I_OUT) { const int nblk = DM / 32, kb = r / nblk, nb = r % nblk; transpose_item(w_out, DM, 64 * kb, 32 * nb, wout_t, DM, 32 * nb, scr, lane); continue; } r -= I_OUT;
            { const int nblk = UPC / 32, kb = r / nblk, nb = r % nblk; const int T = nb >> 3, w = nb & 7;
              const int src = (w < 4) ? (T * 128 + w * 32) : (DFF + T * 128 + (w - 4) * 32);
              transpose_item(w_up, UPC, 64 * kb, src, wup_t, DM, 32 * nb, scr, lane); }
        }
    } else {
        for (int r = gw; r < I_DN; r += NGW) { const int nblk = DM / 32, kb = r / nblk, nb = r % nblk; transpose_item(w_dn, DM, 64 * kb, 32 * nb, wdn_t, DFF, 32 * nb, scr, lane); }
    }
}
__device__ __forceinline__ void ph_mods_reduce(const float* part, const float* b_ada, float* mods, LAS float* red, int tid, int bid, int G) {
    for (int ob = bid; ob < NMODV / 128; ob += G) {
        const int o = tid & 127, pr = tid >> 7; float s = 0.f;
#pragma unroll 4
        for (int i = 0; i < 16; ++i) s += part[(size_t)(pr * 16 + i) * NMODV + ob * 128 + o];
        red[pr * 128 + o] = s; __syncthreads();
        if (tid < 128) { const int j = ob * 128 + tid; float t = (red[tid] + red[128 + tid]) + (red[256 + tid] + red[384 + tid]); t += b_ada[j < 6 * DM ? j : j - 6 * DM]; mods[j] = t; }
        __syncthreads();
    }
}
__device__ __forceinline__ void ph_prenorm(const float* x, const float* ctx, const float* g, const float* mods, bf16* H, int gw, int NGW, int lane) {
    for (int m = gw; m < MROWS; m += NGW) {
        asm volatile("" ::: "memory");
        const bool lat = m < SEQ;
        const GAS f32x4* src = (const GAS f32x4*)(lat ? x + (size_t)m * DM : ctx + (size_t)(m - SEQ) * DM) + lane;
        const f32x4* sh = (const f32x4*)(mods + (lat ? 0 : 6 * DM)) + lane; const f32x4* sc = (const f32x4*)(mods + (lat ? DM : 7 * DM)) + lane; const f32x4* gg = (const f32x4*)g + lane;
        f32x4 v[16]; float ss = 0.f;
#pragma unroll
        for (int j = 0; j < 16; ++j) { v[j] = src[64 * j]; ss += dot4(v[j]); }
        const float rstd = rsqrtf(wave_sum(ss) * (1.0f / DM) + EPSN);
        GAS u32x2v* o8 = (GAS u32x2v*)(H + (size_t)m * DM) + lane;
#pragma unroll
        for (int j = 0; j < 16; ++j) { const f32x4 a = v[j] * rstd * gg[64 * j] * (sc[64 * j] + 1.0f) + sh[64 * j]; u32x2v w; w.x = pk2(a.x, a.y); w.y = pk2(a.z, a.w); o8[64 * j] = w; }
    }
}
__device__ __forceinline__ void ph_qk(const bf16* Z, const float* g_q, const float* g_k, const float* rope, bf16* Qn, bf16* Kn, bf16* Vn, float* lnst, int gw, int NGW, int lane) {
    const int fi = 2 * (lane & 15);
    const f32x2v gq = *(const f32x2v*)(g_q + 2 * lane), gk = *(const f32x2v*)(g_k + 2 * lane);
    for (int m = gw; m < MROWS; m += NGW) {
        const bf16* zr = Z + (size_t)m * INC; const bool lat = m < SEQ;
        const int pos = (lane < 32) ? (m >> 6) : (m & 63);
        f32x2v cs = (f32x2v){1.f, 1.f}, sn = (f32x2v){0.f, 0.f};
        if (lat) { cs = *(const f32x2v*)(rope + pos * 32 + fi); sn = *(const f32x2v*)(rope + 4096 + pos * 32 + fi); }
        const float sgn = (lane & 16) ? 1.0f : -1.0f;
        if (lat) {
#pragma unroll 4
            for (int h = 0; h < NHQ; ++h) {
                const unsigned w = *(const unsigned*)(zr + ZQ0 + h * HD + 2 * lane); float a = bflo(w), b = bfhi(w);
                const float rstd = rsqrtf(wave_sum(a * a + b * b) * (1.0f / HD) + EPSN); a *= rstd * gq.x; b *= rstd * gq.y;
                const float oa = __shfl_xor(a, 16), ob = __shfl_xor(b, 16);
                *(unsigned*)(Qn + (size_t)m * BWID + h * HD + 2 * lane) = pk2(a * cs.x + sgn * oa * sn.x, b * cs.y + sgn * ob * sn.y);
            }
        }
#pragma unroll
        for (int h = 0; h < NKVH; ++h) {
            const unsigned w = *(const unsigned*)(zr + ZK0 + h * HD + 2 * lane); float a = bflo(w), b = bfhi(w);
            const float rstd = rsqrtf(wave_sum(a * a + b * b) * (1.0f / HD) + EPSN); a *= rstd * gk.x; b *= rstd * gk.y;
            const float oa = __shfl_xor(a, 16), ob = __shfl_xor(b, 16);
            *(unsigned*)(Kn + (size_t)m * KVW + h * HD + 2 * lane) = pk2(a * cs.x + sgn * oa * sn.x, b * cs.y + sgn * ob * sn.y);
        }
        *(v4u*)(Vn + (size_t)m * KVW + 8 * lane) = *(const v4u*)(zr + ZV0 + 8 * lane);
        if (lat) {
            float gv[32]; float s = 0.f;
#pragma unroll
            for (int j = 0; j < 4; ++j) { const v4u w = *(const v4u*)(zr + AW + 8 * lane + 512 * j);
                gv[8 * j + 0] = gelu_erf(bflo(w.x)); gv[8 * j + 1] = gelu_erf(bfhi(w.x)); gv[8 * j + 2] = gelu_erf(bflo(w.y)); gv[8 * j + 3] = gelu_erf(bfhi(w.y));
                gv[8 * j + 4] = gelu_erf(bflo(w.z)); gv[8 * j + 5] = gelu_erf(bfhi(w.z)); gv[8 * j + 6] = gelu_erf(bflo(w.w)); gv[8 * j + 7] = gelu_erf(bfhi(w.w)); }
#pragma unroll
            for (int i = 0; i < 32; ++i) s += gv[i];
            const float mean = wave_sum(s) * (1.0f / AW); float q = 0.f;
#pragma unroll
            for (int i = 0; i < 32; ++i) { const float d = gv[i] - mean; q += d * d; }
            const float rstd = rsqrtf(wave_sum(q) * (1.0f / AW) + EPSN);
            if (lane == 0) *(f32x2v*)(lnst + 2 * m) = (f32x2v){mean, rstd};
        }
    }
}
constexpr int CM_LD = 136;
__device__ __forceinline__ void ph_chunk_mlp(const bf16* Z, const float* lnst, const float* ln_g, const float* ln_b, const float* w_s, const float* b_s, bf16* MIX,
                                             LAS unsigned char* lds, int tid, int bid, int G) {
    LAS bf16* As = (LAS bf16*)lds; LAS bf16* Bs = As + 128 * CM_LD;
    const int lane = tid & 63, wid = tid >> 6, r32 = lane & 31, hi = lane >> 5, pb = wid & 3, ch = wid >> 2;
    for (int u = bid; u < 64 * 16; u += G) {
        const int n = u >> 4, g = u & 15;
#pragma unroll
        for (int i = 0; i < 8; ++i) { const int e = (i * 512 + tid) * 4, p = e >> 7, q = e & 127; const f32x4 w = *(const f32x4*)(w_s + (size_t)g * 16384 + e);
            u32x2v o; o.x = pk2(w.x, w.y); o.y = pk2(w.z, w.w); *(LAS u32x2v*)(As + p * CM_LD + q) = o; }
#pragma unroll
        for (int i = 0; i < 4; ++i) { const int e = i * 512 + tid, q = e >> 4, c8 = (e & 15) * 8; const int row = n * 128 + q;
            const v4u w = *(const v4u*)(Z + (size_t)row * INC + AW + g * 128 + c8); const f32x2v st = *(const f32x2v*)(lnst + 2 * row);
            const f32x4 g0 = *(const f32x4*)(ln_g + g * 128 + c8), g1 = *(const f32x4*)(ln_g + g * 128 + c8 + 4), b0 = *(const f32x4*)(ln_b + g * 128 + c8), b1 = *(const f32x4*)(ln_b + g * 128 + c8 + 4);
            float v[8] = {bflo(w.x), bfhi(w.x), bflo(w.y), bfhi(w.y), bflo(w.z), bfhi(w.z), bflo(w.w), bfhi(w.w)};
            const float gm[8] = {g0.x, g0.y, g0.z, g0.w, g1.x, g1.y, g1.z, g1.w}, bt[8] = {b0.x, b0.y, b0.z, b0.w, b1.x, b1.y, b1.z, b1.w};
#pragma unroll
            for (int k = 0; k < 8; ++k) { const float y = (gelu_erf(v[k]) - st.x) * st.y * gm[k] + bt[k]; Bs[(c8 + k) * CM_LD + q] = (bf16)f2bf(y); } }
        __syncthreads();
        f32x16 acc0 = {}, acc1 = {};
#pragma unroll
        for (int ks = 0; ks < 8; ++ks) {
            const bf16x8 a = *(const LAS bf16x8*)(As + (32 * pb + r32) * CM_LD + ks * 16 + hi * 8);
            const bf16x8 b0 = *(const LAS bf16x8*)(Bs + (64 * ch + r32) * CM_LD + ks * 16 + hi * 8);
            const bf16x8 b1 = *(const LAS bf16x8*)(Bs + (64 * ch + 32 + r32) * CM_LD + ks * 16 + hi * 8);
            acc0 = __builtin_amdgcn_mfma_f32_32x32x16_bf16(a, b0, acc0, 0, 0, 0);
            acc1 = __builtin_amdgcn_mfma_f32_32x32x16_bf16(a, b1, acc1, 0, 0, 0);
        }
#pragma unroll
        for (int r = 0; r < 16; ++r) { const int p = 32 * pb + (r & 3) + 8 * (r >> 2) + 4 * hi; const int row = n * 128 + p; const float bs = b_s[g * 128 + p];
            const int c0 = g * 128 + 64 * ch + r32;
            const float u0 = gelu_erf(bf2f(Z[(size_t)row * INC + c0])), u1 = gelu_erf(bf2f(Z[(size_t)row * INC + c0 + 32]));
            MIX[(size_t)row * DM + c0] = (bf16)f2bf(u0 * (acc0[r] + bs)); MIX[(size_t)row * DM + c0 + 32] = (bf16)f2bf(u1 * (acc1[r] + bs)); }
        __syncthreads();
    }
}
__device__ __forceinline__ void ph_mixnorm(bf16* MIX, const float* g_a, const float* g_b, int gw, int NGW, int lane) {
    for (int m = gw; m < SEQ; m += NGW) {
        asm volatile("" ::: "memory");
        GAS v4u* rp = (GAS v4u*)(MIX + (size_t)m * DM) + lane; v4u w[8]; float sa = 0.f, sb = 0.f;
#pragma unroll
        for (int j = 0; j < 8; ++j) { w[j] = rp[64 * j]; const float t = (bflo(w[j].x) * bflo(w[j].x) + bfhi(w[j].x) * bfhi(w[j].x)) + (bflo(w[j].y) * bflo(w[j].y) + bfhi(w[j].y) * bfhi(w[j].y))
                + (bflo(w[j].z) * bflo(w[j].z) + bfhi(w[j].z) * bfhi(w[j].z)) + (bflo(w[j].w) * bflo(w[j].w) + bfhi(w[j].w) * bfhi(w[j].w)); if (j < 4) sa += t; else sb += t; }
        const float ra = rsqrtf(wave_sum(sa) * (1.0f / AW) + EPSN), rb = rsqrtf(wave_sum(sb) * (1.0f / BWID) + EPSN);
#pragma unroll
        for (int j = 0; j < 8; ++j) { const float r = j < 4 ? ra : rb; const float* gp = (j < 4 ? g_a + 512 * j : g_b + 512 * (j - 4)) + 8 * lane;
            const f32x4 g0 = *(const f32x4*)gp, g1 = *(const f32x4*)(gp + 4); v4u o;
            o.x = pk2(bflo(w[j].x) * r * g0.x, bfhi(w[j].x) * r * g0.y); o.y = pk2(bflo(w[j].y) * r * g0.z, bfhi(w[j].y) * r * g0.w);
            o.z = pk2(bflo(w[j].z) * r * g1.x, bfhi(w[j].z) * r * g1.y); o.w = pk2(bflo(w[j].w) * r * g1.z, bfhi(w[j].w) * r * g1.w); rp[64 * j] = o; }
    }
}
__device__ __forceinline__ void ph_postmix(const bf16* O, const float* x, const float* g_post, const float* g_pre2, const float* mods, float* out, bf16* H, LAS float* cl, int tid, int gw, int NGW, int lane) {
    for (int k = tid; k < DM; k += NWAVES * 64) { cl[k] = mods[2 * DM + k] * g_post[k]; cl[DM + k] = g_pre2[k] * (1.0f + mods[4 * DM + k]); cl[2 * DM + k] = mods[3 * DM + k]; }
    __syncthreads();
    const LAS f32x4* cA = (const LAS f32x4*)cl + lane; const LAS f32x4* cB = (const LAS f32x4*)(cl + DM) + lane; const LAS f32x4* cC = (const LAS f32x4*)(cl + 2 * DM) + lane;
    for (int m = gw; m < SEQ; m += NGW) {
        asm volatile("" ::: "memory");
        const GAS u32x2v* op = (const GAS u32x2v*)(O + (size_t)m * DM) + lane; const GAS f32x4* xp = (const GAS f32x4*)(x + (size_t)m * DM) + lane;
        f32x4 v[16]; float ss = 0.f;
#pragma unroll
        for (int j = 0; j < 16; ++j) { const u32x2v w = op[64 * j]; v[j] = (f32x4){bflo(w.x), bfhi(w.x), bflo(w.y), bfhi(w.y)}; ss += dot4(v[j]); }
        const float rstd = rsqrtf(wave_sum(ss) * (1.0f / DM) + EPSN); float s2 = 0.f;
        asm volatile("" ::: "memory");
        GAS f32x4* outp = (GAS f32x4*)(out + (size_t)m * DM) + lane;
#pragma unroll
        for (int j = 0; j < 16; ++j) { v[j] = xp[64 * j] + cA[64 * j] * (v[j] * rstd); s2 += dot4(v[j]); outp[64 * j] = v[j]; }
        const float rstd2 = rsqrtf(wave_sum(s2) * (1.0f / DM) + EPSN);
        asm volatile("" ::: "memory");
        GAS u32x2v* o8 = (GAS u32x2v*)(H + (size_t)m * DM) + lane;
#pragma unroll
        for (int j = 0; j < 16; ++j) { const f32x4 a = v[j] * rstd2 * cB[64 * j] + cC[64 * j]; u32x2v w; w.x = pk2(a.x, a.y); w.y = pk2(a.z, a.w); o8[64 * j] = w; }
    }
    __syncthreads();
}
__device__ __forceinline__ void ph_conv_fix(const float* haloP, const float* haloR, const float* cw, bf16* Gb, int gtid, int NT) {
    constexpr int NCG = (DFF / 128) * 16, NIT = (SEQ / 64) * 2 * NCG;
    for (int it = gtid; it < NIT; it += NT) {
        const int cg = it % NCG, se = it / NCG, seg = se >> 1, e = se & 1, T = cg >> 4, c8 = (cg & 15) * 8;
        const int row = seg * 64 + 63 * e, f0 = T * 128 + c8, tap = e ? 2 : 0, nseg = e ? seg + 1 : seg - 1;
        const bool valid = e ? (seg < SEQ / 64 - 1) : (seg > 0);
        const size_t hb = (size_t)se * UPC + (size_t)T * 256 + c8, nb = (size_t)(nseg * 2 + (e ? 0 : 1)) * UPC + (size_t)T * 256 + c8;
        float o[8];
#pragma unroll
        for (int h = 0; h < 2; ++h) {
            f32x4 ag = *(const f32x4*)(haloP + hb + 4 * h), au = *(const f32x4*)(haloP + hb + 128 + 4 * h);
            if (valid) { const f32x4 rg = *(const f32x4*)(haloR + nb + 4 * h), ru = *(const f32x4*)(haloR + nb + 128 + 4 * h);
                ag += *(const f32x4*)(cw + (size_t)tap * UPC + f0 + 4 * h) * rg; au += *(const f32x4*)(cw + (size_t)tap * UPC + DFF + f0 + 4 * h) * ru; }
            o[4 * h + 0] = silu_f(ag.x) * au.x; o[4 * h + 1] = silu_f(ag.y) * au.y; o[4 * h + 2] = silu_f(ag.z) * au.z; o[4 * h + 3] = silu_f(ag.w) * au.w;
        }
        v4u ov; ov.x = pk2(o[0], o[1]); ov.y = pk2(o[2], o[3]); ov.z = pk2(o[4], o[5]); ov.w = pk2(o[6], o[7]);
        *(v4u*)(Gb + (size_t)row * DFF + f0) = ov;
    }
}
__device__ __forceinline__ void ph_final(const bf16* Fm, const float* g_post, const float* mods, float* out, int gw, int NGW, int lane) {
    const f32x4* gtf = (const f32x4*)(mods + 5 * DM) + lane; const f32x4* gp = (const f32x4*)g_post + lane;
    for (int m = gw; m < SEQ; m += NGW) {
        asm volatile("" ::: "memory");
        const GAS u32x2v* fp = (const GAS u32x2v*)(Fm + (size_t)m * DM) + lane; GAS f32x4* outp = (GAS f32x4*)(out + (size_t)m * DM) + lane;
        f32x4 v[16]; float ss = 0.f;
#pragma unroll
        for (int j = 0; j < 16; ++j) { const u32x2v w = fp[64 * j]; v[j] = (f32x4){bflo(w.x), bfhi(w.x), bflo(w.y), bfhi(w.y)}; ss += dot4(v[j]); }
        const float rstd = rsqrtf(wave_sum(ss) * (1.0f / DM) + EPSN);
#pragma unroll
        for (int j = 0; j < 16; ++j) outp[64 * j] = outp[64 * j] + gtf[64 * j] * (v[j] * rstd * gp[64 * j]);
    }
}

constexpr int NPHASE = 14;
struct Args { const float* in[24]; float* out; unsigned char* ws; int ph_lo, ph_hi; };
__global__ void __launch_bounds__(NWAVES * 64, 2) skel_fwd(Args args) {
    extern __shared__ __attribute__((aligned(16))) unsigned char lds[];
    LAS unsigned char* ldsb = (LAS unsigned char*)lds;
    volatile LAS unsigned* MISC = (volatile LAS unsigned*)(ldsb + MISC_OFF);
    const int wave = __builtin_amdgcn_readfirstlane((int)(threadIdx.x >> 6)); __builtin_assume(wave >= 0 && wave < NWAVES);
#define lane (lane_id())
#define tid (wave * 64 + lane_id())
    const int G = gridDim.x, bid = blockIdx.x;
#define gw (bid * NWAVES + wave)
#define NGW (G * NWAVES)
    unsigned char* ws = args.ws;
    gu32* ctl = (gu32*)(ws + WS_CTL);
#define I_(k) (args.in[k])
#define Xin I_(0)
#define cvec I_(1)
#define ctx I_(2)
#define c_ctx I_(3)
#define w_ada I_(4)
#define b_ada I_(5)
#define g_pre_mix I_(6)
#define g_post_mix I_(7)
#define g_pre_ffn I_(8)
#define g_post_ffn I_(9)
#define w_in I_(10)
#define ln_v_g I_(11)
#define ln_v_b I_(12)
#define w_s I_(13)
#define b_s I_(14)
#define g_q I_(15)
#define g_k I_(16)
#define g_out_a I_(17)
#define g_out_b I_(18)
#define w_out I_(19)
#define w_up I_(20)
#define conv_w I_(21)
#define conv_b I_(22)
#define w_down I_(23)
#define out (args.out)
#define mods ((float*)(ws + WS_MODS))
#define rope ((float*)(ws + WS_ROPE))
#define lnst ((float*)(ws + WS_LNST))
#define part ((float*)(ws + WS_PART))
#define win_t ((bf16*)(ws + WS_WIN))
#define wout_t ((bf16*)(ws + WS_WOUT))
#define wup_t ((bf16*)(ws + WS_WUP))
#define wdn_t ((bf16*)(ws + WS_WDN))
#define Hb ((bf16*)(ws + WS_H))
#define Zb ((bf16*)(ws + WS_Z))
#define Qn ((bf16*)(ws + WS_Q))
#define Kn ((bf16*)(ws + WS_K))
#define Vn ((bf16*)(ws + WS_V))
#define MIX ((bf16*)(ws + WS_MIX))
#define Ob ((bf16*)(ws + WS_O))
#define haloP ((float*)(ws + WS_UP))
#define haloR ((float*)(ws + WS_UP + 24 * MiB))
#define Gb ((bf16*)(ws + WS_G))
    for (int u = tid; u < (LDS_BYTES - LDSCTL_OFF) / 4; u += NWAVES * 64) ((LAS unsigned*)(ldsb + LDSCTL_OFF))[u] = 0u;
    __syncthreads();
    XcdBarrier bar; bar.bar = (unsigned*)(ctl + CW_BAR); bar.x = 0; bar.st = nullptr;
    if (MK_ONE_LAUNCH) bar = xcd_barrier_post((unsigned*)(ctl + CW_BAR), MISC + 8);
#define GRID_BAR() do { if (MK_ONE_LAUNCH) xcd_barrier(bar); } while (0)
    const int lo = args.ph_lo, hi = args.ph_hi;
#ifndef PH_MASK
#define PH_MASK 0xFFFFF
#endif
#define IN(k) (((PH_MASK >> (k)) & 1) && lo <= (k) && (k) < hi)
#define BOTH(k) (IN(k) && IN((k) + 1))

    if (IN(0)) {
        ph_gemv(cvec, c_ctx, w_ada, part, (LAS float*)(ldsb + RING_OFF), tid, bid, G);
        ph_rope_table(rope, tid, bid);
        ph_convert<0>(w_in, w_out, w_up, w_down, win_t, wout_t, wup_t, wdn_t, (LAS float*)(ldsb + RING_OFF + wave * 16384), gw, NGW, lane);
        if (BOTH(0)) GRID_BAR();
    }
    if (IN(1)) { ph_mods_reduce(part, b_ada, mods, (LAS float*)(ldsb + RING_OFF), tid, bid, G); if (BOTH(1)) GRID_BAR(); }
    if (IN(2)) { ph_prenorm(Xin, ctx, g_pre_mix, mods, Hb, gw, NGW, lane); if (BOTH(2)) GRID_BAR(); }
    if (IN(3)) {
        pg8::Gemm g{Hb, win_t, MROWS, INC, DM}; pg8::InOrder S; S.init(G, bid);
        pg8::EpiBf16<0> E{Zb, INC, nullptr, 0, 0, 1.f};
        pg8::gemm_phase<pg8::EpiBf16<0>, pg8::InOrder, PG8_ALIGN, PG8_SP2>(ldsb + RING_OFF, g, S, E, wave);
        { const int rem = (32 * 28 + 4) % G, nconv = rem ? G - rem : G;
          if (bid >= (rem ? rem : 0)) ph_convert<1>(w_in, w_out, w_up, w_down, win_t, wout_t, wup_t, wdn_t, (LAS float*)(ldsb + RING_OFF + wave * 16384), (bid - (rem ? rem : 0)) * NWAVES + wave, nconv * NWAVES, lane); }
        if (BOTH(3)) GRID_BAR();
    }
    if (IN(4)) { ph_qk(Zb, g_q, g_k, rope, Qn, Kn, Vn, lnst, gw, NGW, lane); if (BOTH(4)) GRID_BAR(); }
    if (IN(5)) { ph_chunk_mlp(Zb, lnst, ln_v_g, ln_v_b, w_s, b_s, MIX, ldsb + RING_OFF, tid, bid, G); if (BOTH(5)) GRID_BAR(); }
    if (IN(6)) {
        for (int u = bid; u < NHQ * (SEQ / 256); u += G) {
            const int h = u >> 5, qb = u & 31;
            attn::attn_dense_body<attn::bf16>(Qn + (size_t)qb * 256 * BWID + h * HD, Kn + (h >> 2) * HD, Vn + (h >> 2) * HD, MIX + (size_t)qb * 256 * DM + AW + h * HD, MROWS, (char*)lds + RING_OFF, wave);
            __syncthreads();
        }
        if (BOTH(6)) GRID_BAR();
    }
    if (IN(7)) { ph_mixnorm(MIX, g_out_a, g_out_b, gw, NGW, lane); if (BOTH(7)) GRID_BAR(); }
    if (IN(8)) {
        pg8::Gemm g{MIX, wout_t, SEQ, DM, DM}; pg8::StaticOrder S; S.init(SEQ, DM, G, bid);
        pg8::EpiBf16<0> E{Ob, DM, nullptr, 0, 0, 1.f};
        pg8::gemm_phase<pg8::EpiBf16<0>, pg8::StaticOrder, PG8_ALIGN, PG8_SP2>(ldsb + RING_OFF, g, S, E, wave);
        if (BOTH(8)) GRID_BAR();
    }
    if (IN(9)) { ph_postmix(Ob, Xin, g_post_mix, g_pre_ffn, mods, out, Hb, (LAS float*)(ldsb + RING_OFF), tid, gw, NGW, lane); if (BOTH(9)) GRID_BAR(); }
    if (IN(10)) {
        pg8::Gemm g{Hb, wup_t, SEQ, UPC, DM}; pg8::StaticOrder S; S.init(SEQ, UPC, G, bid);
        pg8::EpiConvGate E{Gb, DFF, DFF, conv_w, conv_b, haloP, haloR};
        pg8::gemm_phase<pg8::EpiConvGate, pg8::StaticOrder, PG8_ALIGN, PG8_SP2>(ldsb + RING_OFF, g, S, E, wave);
        { const int rem = ((SEQ / 256) * (UPC / 256)) % G, nconv = rem ? G - rem : G;
          if (bid >= (rem ? rem : 0)) ph_convert<2>(w_in, w_out, w_up, w_down, win_t, wout_t, wup_t, wdn_t, (LAS float*)(ldsb + RING_OFF + wave * 16384), (bid - (rem ? rem : 0)) * NWAVES + wave, nconv * NWAVES, lane); }
        if (BOTH(10)) GRID_BAR();
    }
    if (IN(11)) { ph_conv_fix(haloP, haloR, conv_w, Gb, bid * (NWAVES * 64) + tid, G * NWAVES * 64); if (BOTH(11)) GRID_BAR(); }
    if (IN(12)) {
        pg8::Gemm g{Gb, wdn_t, SEQ, DM, DFF}; pg8::StaticOrder S; S.init(SEQ, DM, G, bid);
        pg8::EpiBf16<0> E{Ob, DM, nullptr, 0, 0, 1.f};
        pg8::gemm_phase<pg8::EpiBf16<0>, pg8::StaticOrder, PG8_ALIGN, PG8_SP2>(ldsb + RING_OFF, g, S, E, wave);
        if (BOTH(12)) GRID_BAR();
    }
    if (IN(13)) { ph_final(Ob, g_post_ffn, mods, out, gw, NGW, lane); }
#undef IN
#undef BOTH
#undef GRID_BAR
#undef tid
#undef lane
#undef gw
#undef NGW
#undef Xin
#undef cvec
#undef ctx
#undef c_ctx
#undef w_ada
#undef b_ada
#undef g_pre_mix
#undef g_post_mix
#undef g_pre_ffn
#undef g_post_ffn
#undef w_in
#undef ln_v_g
#undef ln_v_b
#undef w_s
#undef b_s
#undef g_q
#undef g_k
#undef g_out_a
#undef g_out_b
#undef w_out
#undef w_up
#undef conv_w
#undef conv_b
#undef w_down
#undef out
#undef mods
#undef rope
#undef lnst
#undef part
#undef win_t
#undef wout_t
#undef wup_t
#undef wdn_t
#undef Hb
#undef Zb
#undef Qn
#undef Kn
#undef Vn
#undef MIX
#undef Ob
#undef haloP
#undef haloR
#undef Gb
}

extern "C" void kernel_launch(void* const* d_in, const int* in_sizes, int n_in, void* d_out, int out_size, void* d_ws, size_t ws_size, hipStream_t stream) {
    static int grid = 0;
    if (grid == 0) {
        if (n_in != 24 || in_sizes[0] != SEQ * DM || out_size != SEQ * DM || ws_size < WS_END) { fprintf(stderr, "kernel_launch: unexpected shapes: n_in %d in0 %d out %d ws %zu (need %zu)\n", n_in, n_in > 0 ? in_sizes[0] : -1, out_size, ws_size, (size_t)WS_END); grid = -1; return; }
        int dev = 0, cus = 0, per_cu = 0;
        if (hipGetDevice(&dev) != hipSuccess || hipDeviceGetAttribute(&cus, hipDeviceAttributeMultiprocessorCount, dev) != hipSuccess) { grid = -1; return; }
        if (hipFuncSetAttribute((const void*)skel_fwd, hipFuncAttributeMaxDynamicSharedMemorySize, LDS_BYTES) != hipSuccess) { fprintf(stderr, "kernel_launch: hipFuncSetAttribute failed\n"); grid = -1; return; }
        if (hipOccupancyMaxActiveBlocksPerMultiprocessor(&per_cu, (const void*)skel_fwd, NWAVES * 64, LDS_BYTES) != hipSuccess || per_cu < 1) fprintf(stderr, "kernel_launch: occupancy query says %d\n", per_cu);
        (void)hipGetLastError();
        grid = cus;
    }
    if (grid < 0) return;
    if (hipMemsetAsync((char*)d_ws + WS_CTL, 0, CTL_ZERO_BYTES, stream) != hipSuccess) return;
    Args a{};
    for (int i = 0; i < 24; ++i) a.in[i] = (const float*)d_in[i];
    a.out = (float*)d_out; a.ws = (unsigned char*)d_ws;
#if MK_ONE_LAUNCH
    a.ph_lo = 0; a.ph_hi = NPHASE;
    hipLaunchKernelGGL(skel_fwd, dim3(grid), dim3(NWAVES * 64), LDS_BYTES, stream, a);
#else
    for (int ph = 0; ph < NPHASE; ++ph) { a.ph_lo = ph; a.ph_hi = ph + 1; hipLaunchKernelGGL(skel_fwd, dim3(grid), dim3(NWAVES * 64), LDS_BYTES, stream, a); }
#endif
    const hipError_t le = hipPeekAtLastError();
    if (le != hipSuccess) fprintf(stderr, "kernel_launch: launch failed: %s\n", hipGetErrorName(le));
}
```

```cpp
#include <hip/hip_runtime.h>
#include <cstdio>
#include <cstdint>
__device__ __forceinline__ int lane_id() { const int l = (int)__builtin_amdgcn_mbcnt_hi(~0u, __builtin_amdgcn_mbcnt_lo(~0u, 0u)); __builtin_assume(l >= 0 && l < 64); return l; }
namespace pg8 {
#define PG8_LAS __attribute__((address_space(3)))
typedef unsigned short bf16_t;
typedef short bf16x8 __attribute__((ext_vector_type(8)));
typedef float f32x4 __attribute__((ext_vector_type(4)));
typedef unsigned u32x4 __attribute__((ext_vector_type(4)));
constexpr int BM = 256, BK = 64, HALF = 128, HTB = HALF * BK * 2  , STAGE_BYTES = 8 * HTB, NXCD = 8, WGM = 8;

__host__ __device__ __forceinline__ int lds_byte(int r, int c) { const int st = (r >> 4) * 2 + (c >> 5), rr = r & 15, cc = c & 31, ob = rr * 64 + cc * 2; return st * 1024 + (ob ^ (((ob >> 9) & 1) << 5)); }
__host__ __device__ __forceinline__ void stage_rc(int b, int& R, int& C) { const int st = b / 1024, sb = b % 1024, swz = sb ^ (((sb >> 9) & 1) << 5); R = (st >> 1) * 16 + swz / 64; C = (st & 1) * 32 + (swz % 64) / 2; }
__host__ __device__ __forceinline__ int perm32(int rho) { const int n = rho >> 4, i = rho & 15; return 8 * (i >> 2) + 4 * n + (i & 3); }

struct Unit { int pm, pn; };
struct Gemm { const bf16_t* A; const bf16_t* Bt; int M, N, K; };

struct StaticOrder {
    int nM, nN, nwg, G, c, nrep = 1;
    __host__ __device__ void init(int M, int N, int G_, int c_) { nM = M / BM; nN = N / BM; nwg = nM * nN; G = G_; c = c_; }
    __host__ __device__ bool next(int i, Unit& u) const {
        long L = (long)i * G + c; if (L >= (long)nwg * nrep) return false; L %= nwg;
        int wgid = (int)L; { const int q = nwg / NXCD, r = nwg % NXCD, xcd = wgid % NXCD, off = wgid / NXCD; wgid = (xcd < r ? xcd * (q + 1) : r * (q + 1) + (xcd - r) * q) + off; }
        const int nig = WGM * nN, gid = wgid / nig, fm = gid * WGM, gsz = (nM - fm) < WGM ? (nM - fm) : WGM;
        u.pm = fm + ((wgid % nig) % gsz); u.pn = (wgid % nig) / gsz; return true;
    }
    __device__ __forceinline__ void a_ready(const Unit&) const {}
    __device__ __forceinline__ void done(const Unit&) const {}
};

struct InOrder : StaticOrder {
    __host__ __device__ void init(int G_, int c_) { StaticOrder::init(32 * BM, 28 * BM, G_, c_); }
    __host__ __device__ bool next(int i, Unit& u) const {
        long L = (long)i * G + c; if (L >= (long)(nwg + 4) * nrep) return false; L %= (nwg + 4);
        if (L >= nwg) { u.pm = 32; u.pn = 24 + (int)(L - nwg); return true; }
        StaticOrder t = *this; t.nrep = 1; t.c = (int)(L % G); return t.next((int)(L / G), u);
    }
};
__device__ __forceinline__ unsigned cvt_pk_bf16(float lo, float hi) { unsigned r; asm volatile("v_cvt_pk_bf16_f32 %0, %1, %2" : "=v"(r) : "v"(lo), "v"(hi)); return r; }
typedef float f32x2 __attribute__((ext_vector_type(2)));
__device__ __forceinline__ f32x2 gelu_pk(f32x2 v) {
    const f32x2 av = __builtin_elementwise_abs(v), d = av * 0.2316418882f + 1.0f;
    f32x2 t; t.x = __builtin_amdgcn_rcpf(d.x); t.y = __builtin_amdgcn_rcpf(d.y);
    f32x2 q = t * 0.5307027145f + (-0.7265760135f); q = q * t + 0.7107068705f; q = q * t + (-0.142248368f); q = q * t + 0.127414796f; q = q * t;
    const f32x2 s = (v * v) * (-0.72134752044f);
    f32x2 e; e.x = __builtin_amdgcn_exp2f(s.x); e.y = __builtin_amdgcn_exp2f(s.y);
    const f32x2 m = v * (q * e), r = v - m;
    f32x2 o; o.x = v.x < 0.f ? m.x : r.x; o.y = v.y < 0.f ? m.y : r.y; return o;
}

template <int ACT  > struct EpiBf16 {
    static constexpr bool PERM = true, AFTER_DRAIN = false; static_assert(ACT == 0 || ACT == 1, "EpiBf16: ACT is 0 (none) or 1 (gelu_pk)");
    bf16_t* O; int ldc; const float* bias; int split_cols; size_t split_stride; float scale0;
    __device__ __forceinline__ void operator()(const f32x4 (&acc)[2][2][4][2], const Unit& u, int wr, int wc, int fr, int fq) const {
        const int row0 = u.pm * BM + wr * 64 + fr; int colt = u.pn * BM; bf16_t* base = O;
        float sc = 1.f; if (split_cols) { const int t = colt / split_cols; base += (size_t)t * split_stride; colt -= t * split_cols; if (t == 0) sc = scale0; }
        const int col0 = colt + wc * 32 + 8 * fq, bcol0 = u.pn * BM + wc * 32 + 8 * fq;
        f32x4 bv[2][2];
#pragma unroll
        for (int bj = 0; bj < 2; ++bj)
#pragma unroll
            for (int n = 0; n < 2; ++n) bv[bj][n] = bias ? *(const f32x4*)(bias + bcol0 + bj * HALF + 4 * n) : (f32x4){0.f, 0.f, 0.f, 0.f};
#pragma unroll
        for (int ai = 0; ai < 2; ++ai)
#pragma unroll
            for (int m = 0; m < 4; ++m) { bf16_t* rowp = base + (size_t)(row0 + ai * HALF + m * 16) * ldc + col0;
#pragma unroll
                for (int bj = 0; bj < 2; ++bj) { f32x4 v0 = acc[ai][bj][m][0] + bv[bj][0], v1 = acc[ai][bj][m][1] + bv[bj][1];
                    if (ACT == 1) { f32x2 a = gelu_pk((f32x2){v0[0], v0[1]}), b = gelu_pk((f32x2){v0[2], v0[3]}), c = gelu_pk((f32x2){v1[0], v1[1]}), d = gelu_pk((f32x2){v1[2], v1[3]});
                        v0 = (f32x4){a.x, a.y, b.x, b.y}; v1 = (f32x4){c.x, c.y, d.x, d.y}; }
                    v0 = v0 * sc; v1 = v1 * sc; u32x4 w; w.x = cvt_pk_bf16(v0[0], v0[1]); w.y = cvt_pk_bf16(v0[2], v0[3]); w.z = cvt_pk_bf16(v1[0], v1[1]); w.w = cvt_pk_bf16(v1[2], v1[3]);
                    *(u32x4*)(rowp + bj * HALF) = w; } }
    }
};
struct EpiF32 {
    static constexpr bool PERM = false, AFTER_DRAIN = false;
    float* C; int ldc; const float* bias;
    __device__ __forceinline__ void operator()(const f32x4 (&acc)[2][2][4][2], const Unit& u, int wr, int wc, int fr, int fq) const {
        const int row0 = u.pm * BM + wr * 64 + fr, col0 = u.pn * BM + wc * 32 + 4 * fq;
        f32x4 bv[2][2];
#pragma unroll
        for (int bj = 0; bj < 2; ++bj)
#pragma unroll
            for (int n = 0; n < 2; ++n) bv[bj][n] = bias ? *(const f32x4*)(bias + col0 + bj * HALF + n * 16) : (f32x4){0.f, 0.f, 0.f, 0.f};
#pragma unroll
        for (int ai = 0; ai < 2; ++ai)
#pragma unroll
            for (int m = 0; m < 4; ++m) { float* rowp = C + (size_t)(row0 + ai * HALF + m * 16) * ldc + col0;
#pragma unroll
                for (int bj = 0; bj < 2; ++bj)
#pragma unroll
                    for (int n = 0; n < 2; ++n) *(f32x4*)(rowp + bj * HALF + n * 16) = acc[ai][bj][m][n] + bv[bj][n]; }
    }
};

template <int CTRL> __device__ __forceinline__ float dpp1(float v) { return __int_as_float(__builtin_amdgcn_update_dpp(0, __float_as_int(v), CTRL, 0xF, 0xF, false)); }
template <int CTRL> __device__ __forceinline__ f32x4 dpp4(f32x4 v) { f32x4 r; r.x = dpp1<CTRL>(v.x); r.y = dpp1<CTRL>(v.y); r.z = dpp1<CTRL>(v.z); r.w = dpp1<CTRL>(v.w); return r; }
__device__ __forceinline__ float silu_fast(float v) { return v * __builtin_amdgcn_rcpf(1.0f + __expf(-v)); }
struct EpiConvGate {
    static constexpr bool PERM = true, AFTER_DRAIN = false;
    bf16_t* Gm; int ldg; int nff; const float* cw; const float* cb; float* haloP; float* haloR;
    __device__ __forceinline__ void operator()(const f32x4 (&acc)[2][2][4][2], const Unit& u, int wr, int wc, int fr, int fq) const {
        const int jc = wc * 32 + 8 * fq, f0 = u.pn * 128 + jc, ldw = 2 * nff;
        f32x4 w[2][3][2], b[2][2];
#pragma unroll
        for (int bj = 0; bj < 2; ++bj)
#pragma unroll
            for (int n = 0; n < 2; ++n) { b[bj][n] = *(const f32x4*)(cb + bj * nff + f0 + 4 * n);
#pragma unroll
                for (int t = 0; t < 3; ++t) w[bj][t][n] = *(const f32x4*)(cw + (size_t)t * ldw + bj * nff + f0 + 4 * n); }
        const f32x4 z4 = (f32x4){0.f, 0.f, 0.f, 0.f};
#pragma unroll
        for (int ai = 0; ai < 2; ++ai) {
            const int row_s = u.pm * BM + ai * HALF + wr * 64, seg = row_s >> 6;
#pragma unroll
            for (int m = 0; m < 4; ++m) {
                f32x4 a[2][2];
#pragma unroll
                for (int bj = 0; bj < 2; ++bj)
#pragma unroll
                    for (int n = 0; n < 2; ++n) {
                        const f32x4 cur = acc[ai][bj][m][n];
                        const f32x4 ps = dpp4<0x121>(cur), pw = (m > 0) ? dpp4<0x121>(acc[ai][bj][m > 0 ? m - 1 : 0][n]) : z4;
                        const f32x4 ns = dpp4<0x12F>(cur), nw = (m < 3) ? dpp4<0x12F>(acc[ai][bj][m < 3 ? m + 1 : 3][n]) : z4;
                        const f32x4 prev = (fr == 0) ? pw : ps, next = (fr == 15) ? nw : ns;
                        a[bj][n] = w[bj][0][n] * prev + w[bj][1][n] * cur + w[bj][2][n] * next + b[bj][n];
                    }
                if ((m == 0 && fr == 0) || (m == 3 && fr == 15)) {
                    const size_t hb = (size_t)(seg * 2 + (m == 0 ? 0 : 1)) * ldw + (size_t)u.pn * 256 + jc;
#pragma unroll
                    for (int bj = 0; bj < 2; ++bj)
#pragma unroll
                        for (int n = 0; n < 2; ++n) { *(f32x4*)(haloP + hb + bj * 128 + 4 * n) = a[bj][n]; *(f32x4*)(haloR + hb + bj * 128 + 4 * n) = acc[ai][bj][m][n]; }
                }
                u32x4 o;
                o.x = cvt_pk_bf16(silu_fast(a[0][0].x) * a[1][0].x, silu_fast(a[0][0].y) * a[1][0].y); o.y = cvt_pk_bf16(silu_fast(a[0][0].z) * a[1][0].z, silu_fast(a[0][0].w) * a[1][0].w);
                o.z = cvt_pk_bf16(silu_fast(a[0][1].x) * a[1][1].x, silu_fast(a[0][1].y) * a[1][1].y); o.w = cvt_pk_bf16(silu_fast(a[0][1].z) * a[1][1].z, silu_fast(a[0][1].w) * a[1][1].w);
                *(u32x4*)(Gm + (size_t)(row_s + m * 16 + fr) * ldg + f0) = o;
            }
        }
    }
};

template <class Epi, class Sched, bool ALIGN_EPI = false, bool SP2 = false>
__device__ __forceinline__ void gemm_phase(PG8_LAS unsigned char* lds, const Gemm g, const Sched& S, const Epi& E, const int wave_) {
    const int lane = lane_id(), wid = wave_; __builtin_assume(lane >= 0 && lane < 64); __builtin_assume(wid >= 0 && wid < 8);
  const int tid = wid * 64 + lane, wr = wid >> 2, wc = wid & 3, fr = lane & 15, fq = lane >> 4;
    const int K = g.K, nt = K / BK;
    unsigned voffA[2], voffB[2];
#pragma unroll
    for (int i = 0; i < 2; ++i) { int R, C; stage_rc(tid * 16 + i * 8192, R, C); const int Rb = Epi::PERM ? ((R & ~31) + perm32(R & 31)) : R;
        voffA[i] = (unsigned)(R * K + C) * 2u; voffB[i] = (unsigned)(Rb * K + C) * 2u; }
    const size_t kstep = (size_t)(BK * 2);
    const size_t hstep = (size_t)HALF * K * 2;
    const size_t tstep = 2 * hstep;
    const unsigned ldsw = (unsigned)wid * 1024u;
    const int aoff = lds_byte(wr * 64 + fr, fq * 8), boff = lds_byte(wc * 32 + fr, fq * 8);
#define PG8_SA(b, h) (((b) * 2 + (h)) * HTB)
#define PG8_SB(b, h) ((4 + (b) * 2 + (h)) * HTB)
#define PG8_STAGE(bufoff, gbase, voff) do { _Pragma("unroll") for (int _i = 0; _i < 2; ++_i) \
        __builtin_amdgcn_global_load_lds((const unsigned*)((const char*)(gbase) + (voff)[_i]), (PG8_LAS unsigned*)(lds + (bufoff) + ldsw + _i * 8192), 16, 0, 0); } while (0)
#define PG8_LDA(dst, b, h) do { _Pragma("unroll") for (int m = 0; m < 4; ++m) _Pragma("unroll") for (int k = 0; k < 2; ++k) dst[m][k] = *(const PG8_LAS bf16x8*)(lds + PG8_SA(b, h) + aoff + m * 2048 + k * 1024); } while (0)
#define PG8_LDB(dst, b, h) do { _Pragma("unroll") for (int n = 0; n < 2; ++n) _Pragma("unroll") for (int k = 0; k < 2; ++k) dst[n][k] = *(const PG8_LAS bf16x8*)(lds + PG8_SB(b, h) + boff + n * 2048 + k * 1024); } while (0)
#define PG8_MMA(ai, bj, At, Bt) do { __builtin_amdgcn_s_setprio(1); _Pragma("unroll") for (int m = 0; m < 4; ++m) _Pragma("unroll") for (int n = 0; n < 2; ++n) _Pragma("unroll") for (int k = 0; k < 2; ++k) \
        acc[ai][bj][m][n] = __builtin_amdgcn_mfma_f32_16x16x32_bf16(Bt[n][k], At[m][k], acc[ai][bj][m][n], 0, 0, 0); __builtin_amdgcn_s_setprio(0); } while (0)
#define PG8_WAIT_V(n) asm volatile("s_waitcnt vmcnt(" #n ")" ::: "memory")
#define PG8_WAIT_L(n) asm volatile("s_waitcnt lgkmcnt(" #n ")" ::: "memory")
#define PG8_BAR __builtin_amdgcn_s_barrier()
#define PG8_SCHED __builtin_amdgcn_sched_barrier(0)
    Unit cur, nxt; int ui = 0;
    if (!S.next(0, cur)) return;
    f32x4 acc[2][2][4][2];
#pragma unroll
    for (int a = 0; a < 2; ++a)
#pragma unroll
        for (int b = 0; b < 2; ++b)
#pragma unroll
            for (int m = 0; m < 4; ++m)
#pragma unroll
                for (int n = 0; n < 2; ++n) acc[a][b][m][n] = (f32x4){0.f, 0.f, 0.f, 0.f};
    bf16x8 At[4][2], B0[2][2], B1[2][2];
    const char* cA = (const char*)g.A + (size_t)cur.pm * tstep; const char* cB = (const char*)g.Bt + (size_t)cur.pn * tstep;
    S.a_ready(cur);
    if constexpr (SP2) {
        PG8_STAGE(PG8_SB(0, 0), cB, voffB); PG8_STAGE(PG8_SB(0, 1), cB + hstep, voffB); PG8_STAGE(PG8_SA(0, 0), cA, voffA); PG8_STAGE(PG8_SA(0, 1), cA + hstep, voffA);
        if (wr == 1) PG8_BAR;
        PG8_WAIT_V(2); PG8_BAR;
        PG8_STAGE(PG8_SB(1, 0), cB + kstep, voffB); PG8_STAGE(PG8_SA(1, 0), cA + kstep, voffA); PG8_STAGE(PG8_SB(1, 1), cB + hstep + kstep, voffB);
        PG8_WAIT_V(6); PG8_BAR;
    } else {
        PG8_STAGE(PG8_SB(0, 0), cB, voffB); PG8_STAGE(PG8_SA(0, 0), cA, voffA); PG8_STAGE(PG8_SB(0, 1), cB + hstep, voffB); PG8_STAGE(PG8_SA(0, 1), cA + hstep, voffA);
        if (wr == 1) PG8_BAR;
        PG8_WAIT_V(4); PG8_BAR;
        PG8_STAGE(PG8_SB(1, 0), cB + kstep, voffB); PG8_STAGE(PG8_SA(1, 0), cA + kstep, voffA); PG8_STAGE(PG8_SB(1, 1), cB + hstep + kstep, voffB);
        PG8_WAIT_V(6); PG8_BAR;
    }
    for (;;) {
        const bool has_next = S.next(ui + 1, nxt);
        const char* nA = has_next ? (const char*)g.A + (size_t)nxt.pm * tstep : cA; const char* nB = has_next ? (const char*)g.Bt + (size_t)nxt.pn * tstep : cB;
        for (int t = 0; t < nt; t += 2) {
            const bool last = (t == nt - 2);
            const char* a1 = cA + (size_t)(t + 1) * kstep;
            const char* a2 = last ? nA : cA + (size_t)(t + 2) * kstep; const char* b2 = last ? nB : cB + (size_t)(t + 2) * kstep;
            const char* a3 = a2 + kstep; const char* b3 = b2 + kstep;
            if (last && has_next) S.a_ready(nxt);
            if constexpr (SP2) {
            PG8_LDB(B0, 0, 0); PG8_LDB(B1, 0, 1); PG8_SCHED; PG8_LDA(At, 0, 0); PG8_STAGE(PG8_SA(1, 1), a1 + hstep, voffA);
            PG8_WAIT_V(8); PG8_WAIT_L(0); PG8_BAR; PG8_MMA(0, 0, At, B0); PG8_MMA(0, 1, At, B1); PG8_BAR; PG8_SCHED;
            PG8_LDA(At, 0, 1); PG8_STAGE(PG8_SB(0, 0), b2, voffB); PG8_STAGE(PG8_SB(0, 1), b2 + hstep, voffB); PG8_STAGE(PG8_SA(0, 0), a2, voffA);
            PG8_WAIT_V(8); PG8_WAIT_L(0); PG8_BAR; PG8_MMA(1, 0, At, B0); PG8_MMA(1, 1, At, B1); PG8_BAR; PG8_SCHED;
            PG8_LDB(B0, 1, 0); PG8_LDB(B1, 1, 1); PG8_SCHED; PG8_LDA(At, 1, 0); PG8_STAGE(PG8_SA(0, 1), a2 + hstep, voffA);
            PG8_WAIT_V(8); PG8_WAIT_L(0); PG8_BAR; PG8_MMA(0, 0, At, B0); PG8_MMA(0, 1, At, B1); PG8_BAR; PG8_SCHED;
            PG8_LDA(At, 1, 1); PG8_STAGE(PG8_SB(1, 0), b3, voffB); PG8_STAGE(PG8_SB(1, 1), b3 + hstep, voffB); PG8_STAGE(PG8_SA(1, 0), a3, voffA);
            PG8_WAIT_V(8); PG8_WAIT_L(0); PG8_BAR; PG8_MMA(1, 0, At, B0); PG8_MMA(1, 1, At, B1); PG8_BAR; PG8_SCHED;
            } else {
            PG8_LDB(B0, 0, 0); PG8_SCHED; PG8_LDA(At, 0, 0); PG8_STAGE(PG8_SA(1, 1), a1 + hstep, voffA);
            PG8_WAIT_L(8); PG8_BAR; PG8_WAIT_L(0); PG8_MMA(0, 0, At, B0); PG8_BAR; PG8_SCHED;
            PG8_LDB(B1, 0, 1); PG8_STAGE(PG8_SB(0, 0), b2, voffB);
            PG8_BAR; PG8_WAIT_L(0); PG8_MMA(0, 1, At, B1); PG8_BAR;
            PG8_LDA(At, 0, 1); PG8_STAGE(PG8_SA(0, 0), a2, voffA);
            PG8_BAR; PG8_WAIT_L(0); PG8_MMA(1, 0, At, B0); PG8_BAR; PG8_SCHED;
            PG8_STAGE(PG8_SB(0, 1), b2 + hstep, voffB);
            PG8_WAIT_V(6); PG8_BAR; PG8_MMA(1, 1, At, B1); PG8_BAR;
            PG8_LDB(B0, 1, 0); PG8_SCHED; PG8_LDA(At, 1, 0); PG8_STAGE(PG8_SA(0, 1), a2 + hstep, voffA);
            PG8_WAIT_L(8); PG8_BAR; PG8_WAIT_L(0); PG8_MMA(0, 0, At, B0); PG8_BAR; PG8_SCHED;
            PG8_LDB(B1, 1, 1); PG8_STAGE(PG8_SB(1, 0), b3, voffB);
            PG8_BAR; PG8_WAIT_L(0); PG8_MMA(0, 1, At, B1); PG8_BAR;
            PG8_LDA(At, 1, 1); PG8_STAGE(PG8_SA(1, 0), a3, voffA);
            PG8_BAR; PG8_WAIT_L(0); PG8_MMA(1, 0, At, B0); PG8_BAR; PG8_SCHED;
            PG8_STAGE(PG8_SB(1, 1), b3 + hstep, voffB);
            PG8_WAIT_V(6); PG8_BAR; PG8_MMA(1, 1, At, B1); PG8_BAR;
            }
        }
        if constexpr (ALIGN_EPI) { if (wr == 0) PG8_BAR; }
        if constexpr (!Epi::AFTER_DRAIN) { E(acc, cur, wr, wc, fr, fq); S.done(cur); }
        if (!has_next) break;
#pragma unroll
        for (int a = 0; a < 2; ++a)
#pragma unroll
            for (int b = 0; b < 2; ++b)
#pragma unroll
                for (int m = 0; m < 4; ++m)
#pragma unroll
                    for (int n = 0; n < 2; ++n) acc[a][b][m][n] = (f32x4){0.f, 0.f, 0.f, 0.f};
        cur = nxt; cA = nA; cB = nB; ++ui;
        if constexpr (ALIGN_EPI) { if (wr == 1) PG8_BAR; }
    }
    PG8_WAIT_V(0);
    if constexpr (!ALIGN_EPI) { if (wr == 0) PG8_BAR; }
    PG8_BAR;
    if constexpr (Epi::AFTER_DRAIN) { E.fused(acc, cur, wr, wc, fr, fq, lds, wid, lane); S.done(cur); }
#undef PG8_SA
#undef PG8_SB
#undef PG8_STAGE
#undef PG8_LDA
#undef PG8_LDB
#undef PG8_MMA
#undef PG8_WAIT_V
#undef PG8_WAIT_L
#undef PG8_BAR
#undef PG8_SCHED
}
}

#ifndef PG8_SP2
#define PG8_SP2 true
#endif
#ifndef PG8_ALIGN
#define PG8_ALIGN true
#endif

namespace attn {
typedef unsigned short bf16;
constexpr int   D = 128, NW = 8, QBLK = 32, KVBLK = 64;
constexpr float SCALE = 0.088388347648318440f;
constexpr float THR = 8.f;
constexpr int SDEPTH = 2;
constexpr int LDQ = 2048, LDK = 512, LDO = 4096;
constexpr size_t SHM_V = KVBLK * D * 2, SHM_K = KVBLK * D * 2, SHM_ATTN = 2 * SHM_V + 2 * SHM_K + NW * 64 * 4;
using bf16x8 = __attribute__((ext_vector_type(8))) short;
using s16x4  = __attribute__((ext_vector_type(4))) short;
using f32x16 = __attribute__((ext_vector_type(16))) float;
using f32x8  = __attribute__((ext_vector_type(8))) float;
using u32x4  = __attribute__((ext_vector_type(4))) unsigned;
#define KSWZ(row, colB) ((row) * 256 + ((colB) ^ (((row) & 7) << 4)))
#define SBAR() __builtin_amdgcn_sched_barrier(0)
__device__ __forceinline__ int crow(int r, int hi) { return (r & 3) + 8 * (r >> 2) + 4 * hi; }
__device__ __forceinline__ unsigned cvtpk(float lo, float hi) {
  unsigned r; asm volatile("v_cvt_pk_bf16_f32 %0, %1, %2" : "=v"(r) : "v"(lo), "v"(hi)); return r;
}
__device__ __forceinline__ bf16 f2bf_rne(float f) { unsigned u = __builtin_bit_cast(unsigned, f); return (bf16)((u + 0x7fffu + ((u >> 16) & 1u)) >> 16); }
template <typename TIn> struct Stage;
template <> struct Stage<bf16>  { using T = bf16x8;
  __device__ static __forceinline__ T ld8(const bf16* p) { return *reinterpret_cast<const bf16x8*>(p); }
  __device__ static __forceinline__ bf16x8 tobf(T x) { return x; } };
template <> struct Stage<float> { using T = f32x8;
  __device__ static __forceinline__ T ld8(const float* p) { return *reinterpret_cast<const f32x8*>(p); }
  __device__ static __forceinline__ bf16x8 tobf(T x) {
    u32x4 w = {cvtpk(x[0], x[1]), cvtpk(x[2], x[3]), cvtpk(x[4], x[5]), cvtpk(x[6], x[7])}; return *reinterpret_cast<bf16x8*>(&w); } };

constexpr float QSCALE = SCALE * 1.4426950408889634f;
__device__ __forceinline__ void partialSM(f32x16& p0, f32x16& p1, float& m_reg, float& mn, float& alpha, const bool fast) {
  if (fast) { mn = 0.f; alpha = 1.f; for (int r = 0; r < 16; ++r) p0[r] = __builtin_amdgcn_exp2f(p0[r]); return; }
  float pmax = p0[0]; for (int r = 1; r < 16; ++r) pmax = fmaxf(pmax, p0[r]); for (int r = 0; r < 16; ++r) pmax = fmaxf(pmax, p1[r]);
  { auto rr = __builtin_amdgcn_permlane32_swap(__float_as_uint(pmax), __float_as_uint(pmax), false, false);
    pmax = fmaxf(__uint_as_float(rr[0]), __uint_as_float(rr[1])); }
  if (__builtin_expect(__all(pmax - m_reg <= THR * 1.4426950408889634f), 1)) { mn = m_reg; alpha = 1.f; }
  else { mn = fmaxf(m_reg, pmax); alpha = __builtin_amdgcn_exp2f(m_reg - mn); m_reg = mn; }
  for (int r = 0; r < 16; ++r) p0[r] -= mn; for (int r = 0; r < 16; ++r) p1[r] -= mn;
  for (int r = 0; r < 16; ++r) p0[r] = __builtin_amdgcn_exp2f(p0[r]);
}
__device__ __forceinline__ void finishSM(f32x16& p0, f32x16& p1, float alpha, float& l_reg, bf16x8& pa0, bf16x8& pa1, bf16x8& pa2, bf16x8& pa3) {
  for (int r = 0; r < 16; ++r) p1[r] = __builtin_amdgcn_exp2f(p1[r]);
  float ps = 0; for (int r = 0; r < 16; ++r) ps += p0[r]; for (int r = 0; r < 16; ++r) ps += p1[r];
  { auto rr = __builtin_amdgcn_permlane32_swap(__float_as_uint(ps), __float_as_uint(ps), false, false);
    ps = __uint_as_float(rr[0]) + __uint_as_float(rr[1]); }
  l_reg = l_reg * alpha + ps;
#define PK4(P, BASE, OUT) do { unsigned a0 = cvtpk(P[BASE + 0], P[BASE + 1]), a1 = cvtpk(P[BASE + 2], P[BASE + 3]);   \
    unsigned b0 = cvtpk(P[BASE + 4], P[BASE + 5]), b1 = cvtpk(P[BASE + 6], P[BASE + 7]);                              \
    auto r0 = __builtin_amdgcn_permlane32_swap(a0, b0, false, false); auto r1 = __builtin_amdgcn_permlane32_swap(a1, b1, false, false); \
    u32x4 w = {r0[0], r1[0], r0[1], r1[1]}; OUT = *reinterpret_cast<bf16x8*>(&w); } while (0)
  PK4(p0, 0, pa0); PK4(p0, 8, pa1); PK4(p1, 0, pa2); PK4(p1, 8, pa3);
#undef PK4
}
__device__ __forceinline__ void qkt(f32x16& p0, f32x16& p1, const bf16* Ks, const bf16x8* qr, int r32, int hi) {
  p0 = f32x16{}; p1 = f32x16{};
  for (int d0 = 0; d0 < 8; ++d0) { int cb = (d0 * 16 + hi * 8) * 2;
    bf16x8 b0 = *reinterpret_cast<const bf16x8*>((const char*)Ks + KSWZ(r32, cb));
    bf16x8 b1 = *reinterpret_cast<const bf16x8*>((const char*)Ks + KSWZ(32 + r32, cb));
    p0 = __builtin_amdgcn_mfma_f32_32x32x16_bf16(b0, qr[d0], p0, 0, 0, 0);
    p1 = __builtin_amdgcn_mfma_f32_32x32x16_bf16(b1, qr[d0], p1, 0, 0, 0); }
}
__device__ __forceinline__ int v_st(int k, int c) { const int kk = (k & ~0xC) | ((k & 4) << 1) | ((k & 8) >> 1); return ((kk >> 3) * 4 + (c >> 5)) * 512 + ((kk & 7) * 32 + (c & 31)) * 2; }
__device__ __forceinline__ int v_rd_base(int lane) { return ((lane & 3) << 3) | (((lane >> 2) & 3) << 6) | (((lane >> 4) & 1) << 5) | (((lane >> 5) & 1) << 8); }
constexpr int v_rd_off(int d0, int ks, int half) { return d0 * 512 + ks * 4096 + half * 2048; }
template <int OFF> __device__ __forceinline__ s16x4 tr_read(int vb) {
  s16x4 r; asm volatile("ds_read_b64_tr_b16 %0, %1 offset:%2" : "=&v"(r) : "v"(vb), "i"(OFF) : "memory"); return r;
}
template <int D0> __device__ __forceinline__ void pv_one(f32x16& od, int vb, bf16x8 pa0, bf16x8 pa1, bf16x8 pa2, bf16x8 pa3) {
  const s16x4 l0 = tr_read<v_rd_off(D0, 0, 0)>(vb), h0 = tr_read<v_rd_off(D0, 0, 1)>(vb), l1 = tr_read<v_rd_off(D0, 1, 0)>(vb), h1 = tr_read<v_rd_off(D0, 1, 1)>(vb);
  const s16x4 l2 = tr_read<v_rd_off(D0, 2, 0)>(vb), h2 = tr_read<v_rd_off(D0, 2, 1)>(vb), l3 = tr_read<v_rd_off(D0, 3, 0)>(vb), h3 = tr_read<v_rd_off(D0, 3, 1)>(vb);
  asm volatile("s_waitcnt lgkmcnt(0)" ::: "memory"); SBAR();
#define PK(L, H) (bf16x8){L[0], L[1], L[2], L[3], H[0], H[1], H[2], H[3]}
  od = __builtin_amdgcn_mfma_f32_32x32x16_bf16(pa0, PK(l0, h0), od, 0, 0, 0);
  od = __builtin_amdgcn_mfma_f32_32x32x16_bf16(pa1, PK(l1, h1), od, 0, 0, 0);
  od = __builtin_amdgcn_mfma_f32_32x32x16_bf16(pa2, PK(l2, h2), od, 0, 0, 0);
  od = __builtin_amdgcn_mfma_f32_32x32x16_bf16(pa3, PK(l3, h3), od, 0, 0, 0);
#undef PK
}
__device__ __forceinline__ void pv_d0(f32x16* o, int vb, bf16x8 pa0, bf16x8 pa1, bf16x8 pa2, bf16x8 pa3) {
  pv_one<0>(o[0], vb, pa0, pa1, pa2, pa3); pv_one<1>(o[1], vb, pa0, pa1, pa2, pa3); pv_one<2>(o[2], vb, pa0, pa1, pa2, pa3); pv_one<3>(o[3], vb, pa0, pa1, pa2, pa3);
}

template <typename TQ>
__device__ __forceinline__ void attn_dense_body(const TQ* __restrict__ Qb, const bf16* __restrict__ Kh, const bf16* __restrict__ Vh,
                                                bf16* __restrict__ Ob, int seq, char* lds, const int wave_, const bool fast) {
  using St = Stage<bf16>; using SQ = Stage<TQ>;
  const int lane = lane_id(), wid = wave_; __builtin_assume(lane >= 0 && lane < 64); __builtin_assume(wid >= 0 && wid < 8);
  const int tid = wid * 64 + lane, r32 = lane & 31, hi = lane >> 5;
  bf16* V_lds = (bf16*)lds; bf16* K_lds = (bf16*)(lds + 2 * SHM_V);
  float* ws = (float*)(lds + 2 * SHM_V + 2 * SHM_K) + wid * 64; float* li_l = ws; float* al_l = ws + 32;
  float m_reg = fast ? 0.f : -1e30f, l_reg = 0; f32x16 o[4] = {}; bf16x8 qr[8];
  const TQ* Qw = Qb + (long)(wid * QBLK + r32) * LDQ + hi * 8;
#pragma unroll
  for (int d0 = 0; d0 < 8; ++d0) qr[d0] = SQ::tobf(SQ::ld8(Qw + d0 * 16));
  const int sr = tid >> 4, sc = (tid & 15) * 8, vst0 = v_st(sr, sc), vst1 = v_st(32 + sr, sc);
  const int vb0 = (int)(uintptr_t)V_lds + v_rd_base(lane);
  struct { typename St::T vs0, vs1, ks0, ks1; } sr_[SDEPTH];
#define SLOAD(i, k0) do { sr_[i].vs0 = St::ld8(&Vh[(long)((k0) + sr) * LDK + sc]); sr_[i].vs1 = St::ld8(&Vh[(long)((k0) + 32 + sr) * LDK + sc]); \
    sr_[i].ks0 = St::ld8(&Kh[(long)((k0) + sr) * LDK + sc]); sr_[i].ks1 = St::ld8(&Kh[(long)((k0) + 32 + sr) * LDK + sc]); } while (0)
#define SWRITE(b, i) do { *(bf16x8*)((char*)V_lds + (b) * SHM_V + vst0) = St::tobf(sr_[i].vs0);          \
    *(bf16x8*)((char*)V_lds + (b) * SHM_V + vst1) = St::tobf(sr_[i].vs1); int kc = sc * 2;               \
    *(bf16x8*)((char*)K_lds + (b) * SHM_K + KSWZ(sr, kc)) = St::tobf(sr_[i].ks0);                       \
    *(bf16x8*)((char*)K_lds + (b) * SHM_K + KSWZ(32 + sr, kc)) = St::tobf(sr_[i].ks1); } while (0)
#define SWAIT() do { if constexpr (SDEPTH == 2) asm volatile("s_waitcnt vmcnt(4)" ::: "memory"); else asm volatile("s_waitcnt vmcnt(0)" ::: "memory"); } while (0)
#define RESC(a) do { if (__any((a) < 1.f)) { if (hi == 0) al_l[r32] = (a); asm volatile("s_waitcnt lgkmcnt(0)" ::: "memory"); \
    for (int d = 0; d < 4; ++d) for (int r = 0; r < 16; ++r) o[d][r] *= al_l[crow(r, hi)]; } } while (0)
  f32x16 pA0, pA1, pB0, pB1; float mnA, mnB, alA, alB; bf16x8 pa0, pa1, pa2, pa3; const int NT = seq / KVBLK;
  constexpr int SE = 0, SO = SDEPTH - 1;
  SLOAD(SE, 0); asm volatile("s_waitcnt vmcnt(0)" ::: "memory"); SWRITE(0, SE); __syncthreads();
  qkt(pA0, pA1, K_lds, qr, r32, hi); partialSM(pA0, pA1, m_reg, mnA, alA, fast);
  SLOAD(SO, KVBLK); if constexpr (SDEPTH == 2) { if (2 < NT) SLOAD(SE, 2 * KVBLK); }
  SWAIT(); SWRITE(1, SO); __syncthreads();
  for (int j = 1; j + 1 < NT; j += 2) {
    SBAR(); qkt(pB0, pB1, (bf16*)((char*)K_lds + SHM_K), qr, r32, hi);
    finishSM(pA0, pA1, alA, l_reg, pa0, pa1, pa2, pa3); SBAR();
    SLOAD(SO, (j + SDEPTH) * KVBLK); SBAR();
    pv_d0(o, vb0, pa0, pa1, pa2, pa3); partialSM(pB0, pB1, m_reg, mnB, alB, fast);
    __syncthreads(); SWAIT(); SWRITE(0, SE);
    RESC(alB); __syncthreads();
    SBAR(); qkt(pA0, pA1, K_lds, qr, r32, hi);
    finishSM(pB0, pB1, alB, l_reg, pa0, pa1, pa2, pa3); SBAR();
    if (SDEPTH == 1 || j + 3 < NT) SLOAD(SE, (j + 1 + SDEPTH) * KVBLK); SBAR();
    pv_d0(o, vb0 + (int)SHM_V, pa0, pa1, pa2, pa3); partialSM(pA0, pA1, m_reg, mnA, alA, fast);
    __syncthreads(); SWAIT(); SWRITE(1, SO);
    RESC(alA); __syncthreads();
  }
  SBAR(); qkt(pB0, pB1, (bf16*)((char*)K_lds + SHM_K), qr, r32, hi);
  finishSM(pA0, pA1, alA, l_reg, pa0, pa1, pa2, pa3); SBAR();
  pv_d0(o, vb0, pa0, pa1, pa2, pa3); partialSM(pB0, pB1, m_reg, mnB, alB, fast);
  __syncthreads(); RESC(alB);
  finishSM(pB0, pB1, alB, l_reg, pa0, pa1, pa2, pa3); SBAR();
  pv_d0(o, vb0 + (int)SHM_V, pa0, pa1, pa2, pa3);
  if (hi == 0) li_l[r32] = l_reg; asm volatile("s_waitcnt lgkmcnt(0)" ::: "memory");
  float rli[16];
#pragma unroll
  for (int r = 0; r < 16; ++r) rli[r] = __builtin_amdgcn_rcpf(li_l[crow(r, hi)]);
  bf16* Ow = Ob + (long)(wid * QBLK) * LDO;
#pragma unroll
  for (int r = 0; r < 16; ++r) { int orow = crow(r, hi);
    for (int d0 = 0; d0 < 4; ++d0) Ow[(long)orow * LDO + d0 * 32 + r32] = f2bf_rne(o[d0][r] * rli[r]); }
#undef SLOAD
#undef SWRITE
#undef SWAIT
#undef RESC
}
}

constexpr int NWAVES = 8;
#ifndef MK_ONE_LAUNCH
#define MK_ONE_LAUNCH 1
#endif

constexpr int DM = 4096, SEQ = 8192, CTXN = 256, MROWS = SEQ + CTXN;
constexpr int AW = 2048, BWID = 2048, HD = 128, NHQ = 16, NKVH = 4, KVW = 512;
constexpr int INC = 7168, DFF = 11008, UPC = 2 * DFF;
constexpr int ZQ0 = 4096, ZK0 = 6144, ZV0 = 6656;
constexpr float EPSN = 1e-6f;
constexpr int NMODV = 32768;

constexpr size_t MiB = 1u << 20;
constexpr size_t WS_CTL = 0, CTL_ZERO_BYTES = 1 * MiB;
constexpr size_t WS_MODS = 1 * MiB;
constexpr size_t WS_ROPE = 1 * MiB + 256 * 1024;
constexpr size_t WS_LNST = 2 * MiB;
constexpr size_t WS_PART = 4 * MiB;
constexpr size_t WS_WIN = 16 * MiB, WS_WOUT = 72 * MiB, WS_WUP = 104 * MiB, WS_WDN = 276 * MiB;
constexpr size_t WS_H = 362 * MiB;
constexpr size_t WS_Z = 428 * MiB;
constexpr size_t WS_Q = 544 * MiB, WS_K = 576 * MiB, WS_V = 585 * MiB;
constexpr size_t WS_MIX = 594 * MiB;
constexpr size_t WS_O = 658 * MiB;
constexpr size_t WS_UP = 786 * MiB;
constexpr size_t WS_G = 1130 * MiB;
constexpr size_t WS_END = 1302 * MiB;
constexpr int CW_BAR = 4096;

constexpr int RING_OFF = 0, RING_BYTES = 131072;
constexpr int LDSCTL_OFF = RING_BYTES, MISC_OFF = LDSCTL_OFF + 320;
constexpr int LDS_BYTES = 147456;

#define GAS __attribute__((address_space(1)))
#define LAS __attribute__((address_space(3)))
typedef unsigned short bf16;
typedef unsigned v4u __attribute__((ext_vector_type(4)));
typedef float f32x4 __attribute__((ext_vector_type(4)));
typedef short bf16x8 __attribute__((ext_vector_type(8)));
typedef GAS unsigned gu32;
typedef GAS unsigned long long gu64;
#define RLX_AGENT __ATOMIC_RELAXED, __HIP_MEMORY_SCOPE_AGENT
#define LDS_WAIT() asm volatile("s_waitcnt lgkmcnt(0)" ::: "memory")
#define VM_WAIT() asm volatile("s_waitcnt vmcnt(0)" ::: "memory")
__device__ __forceinline__ unsigned long long rt() { return __builtin_amdgcn_s_memrealtime(); }
__device__ __forceinline__ unsigned f2bf(float f) { unsigned u = __builtin_bit_cast(unsigned, f); return (u + 0x7fffu + ((u >> 16) & 1u)) >> 16; }
__device__ __forceinline__ unsigned pk2(float lo, float hi) { return f2bf(lo) | (f2bf(hi) << 16); }

#define XB_TMO      128
#define XB_XCNT(j)  (256  + 64 * (j))
#define XB_XSUB(j)  (1280 + 64 * (j))
#define XB_XGEN(j)  (2304 + 64 * (j))
#define XB_TOP      3328
#define XB_TOPGEN   3392
#define XCD_BAR_WORDS 3456
#define XB_SPIN_CAP (1u << 18)

__device__ __forceinline__ unsigned xb_ld(unsigned* p)              { return __hip_atomic_load(p, __ATOMIC_RELAXED, __HIP_MEMORY_SCOPE_AGENT); }
__device__ __forceinline__ unsigned xb_add(unsigned* p, unsigned v) { return __hip_atomic_fetch_add(p, v, __ATOMIC_RELAXED, __HIP_MEMORY_SCOPE_AGENT); }
__device__ __forceinline__ unsigned xb_xcc_id() { return (unsigned)__builtin_amdgcn_s_getreg((3 << 11) | 20) & 0xFu; }
#define XB_SPIN(cond, bar) do { unsigned _sp = 0; while (cond) { __builtin_amdgcn_s_sleep(1); \
    if ((++_sp & 255u) == 0u) { if (xb_ld(&(bar)[XB_TMO])) break; if (_sp > XB_SPIN_CAP) { atomicAdd(&(bar)[XB_TMO], 1u); break; } } } } while (0)

struct XcdBarrier {
    unsigned* bar; unsigned x;
    volatile LAS unsigned* st;
};

__device__ __forceinline__ XcdBarrier xcd_barrier_post(unsigned* bar, volatile LAS unsigned* st) {
    XcdBarrier b; b.bar = bar; b.x = xb_xcc_id(); b.st = st;
    if (threadIdx.x == 0) (void)xb_add(&bar[XB_XCNT(b.x)], 1u);
    return b;
}
__device__ __forceinline__ void xcd_barrier_complete(unsigned* bar, unsigned x, unsigned& nloc, unsigned& nx) {
    const unsigned G = gridDim.x * gridDim.y * gridDim.z;
    unsigned sum, cnt, mine, sp = 0u;
    for (;;) {
        sum = 0u; cnt = 0u; mine = 0u;
#pragma unroll
        for (unsigned j = 0; j < 16; ++j) { const unsigned c = xb_ld(&bar[XB_XCNT(j)]); sum += c; cnt += (c > 0u) ? 1u : 0u; mine = (j == x) ? c : mine; }
        if (sum == G) break;
        __builtin_amdgcn_s_sleep(1);
        if ((++sp & 255u) == 0u) { if (xb_ld(&bar[XB_TMO])) break; if (sp > XB_SPIN_CAP) { atomicAdd(&bar[XB_TMO], 1u); break; } }
    }
    nloc = mine > 0u ? mine : 1u; nx = cnt > 0u ? cnt : 1u;
}

__device__ __forceinline__ void xcd_barrier(const XcdBarrier& b) {
    asm volatile("s_waitcnt vmcnt(0)" ::: "memory");
    __syncthreads();
    if (threadIdx.x == 0) {
        unsigned* bar = b.bar;
        __builtin_amdgcn_s_waitcnt(0);
        unsigned nloc = b.st[0], nx = b.st[1];
        if (nloc == 0u) { xcd_barrier_complete(bar, b.x, nloc, nx); b.st[0] = nloc; b.st[1] = nx; }
        const unsigned old = xb_add(&bar[XB_XSUB(b.x)], 1u);
        const unsigned gen = old / nloc;
        if (old + 1u == (gen + 1u) * nloc) {
            __builtin_amdgcn_fence(__ATOMIC_RELEASE, "agent");
            asm volatile("s_waitcnt vmcnt(0)" ::: "memory");
            const unsigned og = xb_add(&bar[XB_TOP], 1u);
            const unsigned tg = og / nx;
            if (og + 1u == (tg + 1u) * nx) xb_add(&bar[XB_TOPGEN], 1u);
            else XB_SPIN(xb_ld(&bar[XB_TOPGEN]) == tg, bar);
            __builtin_amdgcn_fence(__ATOMIC_ACQUIRE, "agent");
            xb_add(&bar[XB_XGEN(b.x)], 1u);
            asm volatile("s_waitcnt vmcnt(0)" ::: "memory");
        } else {
            XB_SPIN(xb_ld(&bar[XB_XGEN(b.x)]) == gen, bar);
            __builtin_amdgcn_fence(__ATOMIC_ACQUIRE, "agent");
            asm volatile("s_waitcnt vmcnt(0)" ::: "memory");
        }
    }
    __syncthreads();
}

typedef float f32x2v __attribute__((ext_vector_type(2)));
typedef unsigned u32x2v __attribute__((ext_vector_type(2)));
typedef float f32x16 __attribute__((ext_vector_type(16)));
__device__ __forceinline__ float wave_sum(float v) {
#pragma unroll
    for (int o = 1; o < 64; o <<= 1) v += __shfl_xor(v, o);
    return v;
}
__device__ __forceinline__ float bflo(unsigned w) { return __uint_as_float(w << 16); }
__device__ __forceinline__ float bfhi(unsigned w) { return __uint_as_float(w & 0xffff0000u); }
__device__ __forceinline__ float bf2f(bf16 b) { return __uint_as_float(((unsigned)b) << 16); }
__device__ __forceinline__ float gelu_erf(float v) { return 0.5f * v * (1.0f + erff(v * 0.70710678118654752f)); }
__device__ __forceinline__ float silu_f(float v) { return v / (1.0f + __expf(-v)); }
__device__ __forceinline__ float dot4(f32x4 a) { return (a.x * a.x + a.y * a.y) + (a.z * a.z + a.w * a.w); }

__device__ __forceinline__ void ph_gemv(const float* c, const float* cx, const float* w_ada, float* part, LAS float* sl, int tid, int bid, int G) {
    for (int k = tid; k < DM; k += NWAVES * 64) { const float a = c[k]; sl[k] = a / (1.0f + expf(-a)); const float b = cx[k]; sl[DM + k] = b / (1.0f + expf(-b)); }
    __syncthreads();
    const int half = tid >> 8, tx = tid & 255;
    for (int it = bid; it < 768; it += G) {
        const int jt = it % 24, ks = it / 24;
        const int j0 = jt * 1024 + tx * 4, kbase = ks * 128 + half * 64;
        const f32x4* wp = (const f32x4*)(w_ada + (size_t)kbase * (6 * DM) + j0);
        f32x4 ac = (f32x4){0.f, 0.f, 0.f, 0.f}, ax = (f32x4){0.f, 0.f, 0.f, 0.f};
#pragma unroll 8
        for (int i = 0; i < 64; ++i) { const f32x4 w = wp[(size_t)i * (6 * DM / 4)]; const float sc = sl[kbase + i], sx = sl[DM + kbase + i]; ac += w * sc; ax += w * sx; }
        float* po = part + (size_t)(ks * 2 + half) * NMODV;
        *(f32x4*)(po + j0) = ac;
        if (jt < 8) *(f32x4*)(po + 6 * DM + j0) = ax;
    }
    __syncthreads();
}
__device__ __forceinline__ void ph_rope_table(float* rope, int tid, int bid) {
    const int gid = bid * (NWAVES * 64) + tid;
    if (gid < 4096) { const int pos = gid >> 5, i = gid & 31; const float fr = powf(10000.0f, -(float)i / 32.0f); const float ang = (float)pos * fr; rope[gid] = cosf(ang); rope[4096 + gid] = sinf(ang); }
}
struct TrItem { const float* src; bf16* dst; int N, K; };
__device__ __forceinline__ void tr_load(const TrItem& t, f32x4 (&v)[16], int lane) {
    const float* p = t.src + (size_t)(8 * (lane >> 4)) * t.N + 4 * (lane & 15);
#pragma unroll
    for (int i = 0; i < 16; ++i) v[i] = *(const GAS f32x4*)(p + (size_t)((i & 7) + 32 * (i >> 3)) * t.N);
}
__device__ __forceinline__ void tr_store(const TrItem& t, const f32x4 (&v)[16], int lane) {
    bf16* q = t.dst + (size_t)(4 * (lane & 15)) * t.K + 8 * (lane >> 4);
#pragma unroll
    for (int j = 0; j < 4; ++j)
#pragma unroll
        for (int h = 0; h < 2; ++h) { v4u o; o.x = pg8::cvt_pk_bf16(v[8 * h + 0][j], v[8 * h + 1][j]); o.y = pg8::cvt_pk_bf16(v[8 * h + 2][j], v[8 * h + 3][j]);
            o.z = pg8::cvt_pk_bf16(v[8 * h + 4][j], v[8 * h + 5][j]); o.w = pg8::cvt_pk_bf16(v[8 * h + 6][j], v[8 * h + 7][j]); *(GAS v4u*)(q + (size_t)j * t.K + 32 * h) = o; }
}
template <int WHICH  >
__device__ __forceinline__ TrItem tr_item(int it, const float* w_in, const float* w_out, const float* w_up, const float* w_dn, bf16* win_t, bf16* wout_t, bf16* wup_t, bf16* wdn_t) {
    TrItem t;
    if constexpr (WHICH == 0) { const int nblk = INC / 64, kb = it / nblk, nb = it % nblk; t.src = w_in + (size_t)(64 * kb) * INC + 64 * nb; t.N = INC; t.dst = win_t + (size_t)(64 * nb) * DM + 64 * kb; t.K = DM; }
    else if constexpr (WHICH == 1) {
        constexpr int I_OUT = (DM / 64) * (DM / 64);
        if (it < I_OUT) { const int nblk = DM / 64, kb = it / nblk, nb = it % nblk; t.src = w_out + (size_t)(64 * kb) * DM + 64 * nb; t.N = DM; t.dst = wout_t + (size_t)(64 * nb) * DM + 64 * kb; t.K = DM; }
        else { const int r = it - I_OUT, nblk = UPC / 64, kb = r / nblk, nb = r % nblk, T = nb >> 2, w = nb & 3;
            const int srcn = (w < 2) ? (T * 128 + w * 64) : (DFF + T * 128 + (w - 2) * 64);
            t.src = w_up + (size_t)(64 * kb) * UPC + srcn; t.N = UPC; t.dst = wup_t + (size_t)(64 * nb) * DM + 64 * kb; t.K = DM; }
    } else { const int nblk = DM / 64, kb = it / nblk, nb = it % nblk; t.src = w_dn + (size_t)(64 * kb) * DM + 64 * nb; t.N = DM; t.dst = wdn_t + (size_t)(64 * nb) * DFF + 64 * kb; t.K = DFF; }
    return t;
}
template <int WHICH>
__device__ __forceinline__ void ph_convert(const float* w_in, const float* w_out, const float* w_up, const float* w_dn, bf16* win_t, bf16* wout_t, bf16* wup_t, bf16* wdn_t, int gw, int NGW, int lane) {
    constexpr int NIT = WHICH == 0 ? (DM / 64) * (INC / 64) : WHICH == 1 ? (DM / 64) * (DM / 64) + (DM / 64) * (UPC / 64) : (DFF / 64) * (DM / 64);
    for (int it = gw; it < NIT; it += 2 * NGW) {
        f32x4 va[16], vb[16]; const bool two = it + NGW < NIT;
        const TrItem ta = tr_item<WHICH>(it, w_in, w_out, w_up, w_dn, win_t, wout_t, wup_t, wdn_t);
        const TrItem tb = tr_item<WHICH>(two ? it + NGW : it, w_in, w_out, w_up, w_dn, win_t, wout_t, wup_t, wdn_t);
        tr_load(ta, va, lane); if (two) tr_load(tb, vb, lane);
        tr_store(ta, va, lane); if (two) tr_store(tb, vb, lane);
    }
}
__device__ __forceinline__ void ph_mods_reduce(const float* part, const float* b_ada, float* mods, LAS float* red, int tid, int bid, int G) {
    for (int ob = bid; ob < NMODV / 128; ob += G) {
        const int o = tid & 127, pr = tid >> 7; float s = 0.f;
#pragma unroll 4
        for (int i = 0; i < 16; ++i) s += part[(size_t)(pr * 16 + i) * NMODV + ob * 128 + o];
        red[pr * 128 + o] = s; __syncthreads();
        if (tid < 128) { const int j = ob * 128 + tid; float t = (red[tid] + red[128 + tid]) + (red[256 + tid] + red[384 + tid]); t += b_ada[j < 6 * DM ? j : j - 6 * DM]; mods[j] = t; }
        __syncthreads();
    }
}
__device__ __forceinline__ void ph_prenorm(const float* x, const float* ctx, const float* g, const float* mods, bf16* H, int gw, int NGW, int lane) {
    for (int m = gw; m < MROWS; m += NGW) {
        asm volatile("" ::: "memory");
        const bool lat = m < SEQ;
        const GAS f32x4* src = (const GAS f32x4*)(lat ? x + (size_t)m * DM : ctx + (size_t)(m - SEQ) * DM) + lane;
        const f32x4* sh = (const f32x4*)(mods + (lat ? 0 : 6 * DM)) + lane; const f32x4* sc = (const f32x4*)(mods + (lat ? DM : 7 * DM)) + lane; const f32x4* gg = (const f32x4*)g + lane;
        f32x4 v[16]; float ss = 0.f;
#pragma unroll
        for (int j = 0; j < 16; ++j) { v[j] = src[64 * j]; ss += dot4(v[j]); }
        const float rstd = rsqrtf(wave_sum(ss) * (1.0f / DM) + EPSN);
        GAS u32x2v* o8 = (GAS u32x2v*)(H + (size_t)m * DM) + lane;
#pragma unroll
        for (int j = 0; j < 16; ++j) { const f32x4 a = v[j] * rstd * gg[64 * j] * (sc[64 * j] + 1.0f) + sh[64 * j]; u32x2v w; w.x = pk2(a.x, a.y); w.y = pk2(a.z, a.w); o8[64 * j] = w; }
    }
}
__device__ __forceinline__ void ph_qk(const bf16* Z, const float* g_q, const float* g_k, const float* rope, bf16* Qn, bf16* Kn, bf16* Vn, float* lnst, int gw, int NGW, int lane) {
    const int fi = 2 * (lane & 15);
    const f32x2v gq = *(const f32x2v*)(g_q + 2 * lane), gk = *(const f32x2v*)(g_k + 2 * lane);
    for (int m = gw; m < MROWS; m += NGW) {
        const bf16* zr = Z + (size_t)m * INC; const bool lat = m < SEQ;
        const int pos = (lane < 32) ? (m >> 6) : (m & 63);
        f32x2v cs = (f32x2v){1.f, 1.f}, sn = (f32x2v){0.f, 0.f};
        if (lat) { cs = *(const f32x2v*)(rope + pos * 32 + fi); sn = *(const f32x2v*)(rope + 4096 + pos * 32 + fi); }
        const float sgn = (lane & 16) ? 1.0f : -1.0f;
        if (lat) {
#pragma unroll 4
            for (int h = 0; h < NHQ; ++h) {
                const unsigned w = *(const unsigned*)(zr + ZQ0 + h * HD + 2 * lane); float a = bflo(w), b = bfhi(w);
                const float rstd = rsqrtf(wave_sum(a * a + b * b) * (1.0f / HD) + EPSN); a *= rstd * gq.x; b *= rstd * gq.y;
                const float oa = __shfl_xor(a, 16), ob = __shfl_xor(b, 16);
                *(unsigned*)(Qn + (size_t)m * BWID + h * HD + 2 * lane) = pk2((a * cs.x + sgn * oa * sn.x) * attn::QSCALE, (b * cs.y + sgn * ob * sn.y) * attn::QSCALE);
            }
        }
#pragma unroll
        for (int h = 0; h < NKVH; ++h) {
            const unsigned w = *(const unsigned*)(zr + ZK0 + h * HD + 2 * lane); float a = bflo(w), b = bfhi(w);
            const float rstd = rsqrtf(wave_sum(a * a + b * b) * (1.0f / HD) + EPSN); a *= rstd * gk.x; b *= rstd * gk.y;
            const float oa = __shfl_xor(a, 16), ob = __shfl_xor(b, 16);
            *(unsigned*)(Kn + (size_t)m * KVW + h * HD + 2 * lane) = pk2(a * cs.x + sgn * oa * sn.x, b * cs.y + sgn * ob * sn.y);
        }
        *(v4u*)(Vn + (size_t)m * KVW + 8 * lane) = *(const v4u*)(zr + ZV0 + 8 * lane);
        if (lat) {
            float gv[32]; float s = 0.f;
#pragma unroll
            for (int j = 0; j < 4; ++j) { const v4u w = *(const v4u*)(zr + AW + 8 * lane + 512 * j);
                gv[8 * j + 0] = gelu_erf(bflo(w.x)); gv[8 * j + 1] = gelu_erf(bfhi(w.x)); gv[8 * j + 2] = gelu_erf(bflo(w.y)); gv[8 * j + 3] = gelu_erf(bfhi(w.y));
                gv[8 * j + 4] = gelu_erf(bflo(w.z)); gv[8 * j + 5] = gelu_erf(bfhi(w.z)); gv[8 * j + 6] = gelu_erf(bflo(w.w)); gv[8 * j + 7] = gelu_erf(bfhi(w.w)); }
#pragma unroll
            for (int i = 0; i < 32; ++i) s += gv[i];
            const float mean = wave_sum(s) * (1.0f / AW); float q = 0.f;
#pragma unroll
            for (int i = 0; i < 32; ++i) { const float d = gv[i] - mean; q += d * d; }
            const float rstd = rsqrtf(wave_sum(q) * (1.0f / AW) + EPSN);
            if (lane == 0) *(f32x2v*)(lnst + 2 * m) = (f32x2v){mean, rstd};
        }
    }
}
constexpr int CM_LD = 136;
__device__ __forceinline__ void ph_chunk_mlp(const bf16* Z, const float* lnst, const float* ln_g, const float* ln_b, const float* w_s, const float* b_s, bf16* MIX,
                                             LAS unsigned char* lds, int tid, int bid, int G) {
    LAS bf16* As = (LAS bf16*)lds; LAS bf16* Bs = As + 128 * CM_LD;
    const int lane = tid & 63, wid = tid >> 6, r32 = lane & 31, hi = lane >> 5, pb = wid & 3, ch = wid >> 2;
    for (int u = bid; u < 64 * 16; u += G) {
        const int n = u >> 4, g = u & 15;
#pragma unroll
        for (int i = 0; i < 8; ++i) { const int e = (i * 512 + tid) * 4, p = e >> 7, q = e & 127; const f32x4 w = *(const f32x4*)(w_s + (size_t)g * 16384 + e);
            u32x2v o; o.x = pk2(w.x, w.y); o.y = pk2(w.z, w.w); *(LAS u32x2v*)(As + p * CM_LD + q) = o; }
#pragma unroll
        for (int i = 0; i < 4; ++i) { const int e = i * 512 + tid, q = e >> 4, c8 = (e & 15) * 8; const int row = n * 128 + q;
            const v4u w = *(const v4u*)(Z + (size_t)row * INC + AW + g * 128 + c8); const f32x2v st = *(const f32x2v*)(lnst + 2 * row);
            const f32x4 g0 = *(const f32x4*)(ln_g + g * 128 + c8), g1 = *(const f32x4*)(ln_g + g * 128 + c8 + 4), b0 = *(const f32x4*)(ln_b + g * 128 + c8), b1 = *(const f32x4*)(ln_b + g * 128 + c8 + 4);
            float v[8] = {bflo(w.x), bfhi(w.x), bflo(w.y), bfhi(w.y), bflo(w.z), bfhi(w.z), bflo(w.w), bfhi(w.w)};
            const float gm[8] = {g0.x, g0.y, g0.z, g0.w, g1.x, g1.y, g1.z, g1.w}, bt[8] = {b0.x, b0.y, b0.z, b0.w, b1.x, b1.y, b1.z, b1.w};
#pragma unroll
            for (int k = 0; k < 8; ++k) { const float y = (gelu_erf(v[k]) - st.x) * st.y * gm[k] + bt[k]; Bs[(c8 + k) * CM_LD + q] = (bf16)f2bf(y); } }
        __syncthreads();
        f32x16 acc0 = {}, acc1 = {};
#pragma unroll
        for (int ks = 0; ks < 8; ++ks) {
            const bf16x8 a = *(const LAS bf16x8*)(As + (32 * pb + r32) * CM_LD + ks * 16 + hi * 8);
            const bf16x8 b0 = *(const LAS bf16x8*)(Bs + (64 * ch + r32) * CM_LD + ks * 16 + hi * 8);
            const bf16x8 b1 = *(const LAS bf16x8*)(Bs + (64 * ch + 32 + r32) * CM_LD + ks * 16 + hi * 8);
            acc0 = __builtin_amdgcn_mfma_f32_32x32x16_bf16(a, b0, acc0, 0, 0, 0);
            acc1 = __builtin_amdgcn_mfma_f32_32x32x16_bf16(a, b1, acc1, 0, 0, 0);
        }
#pragma unroll
        for (int r = 0; r < 16; ++r) { const int p = 32 * pb + (r & 3) + 8 * (r >> 2) + 4 * hi; const int row = n * 128 + p; const float bs = b_s[g * 128 + p];
            const int c0 = g * 128 + 64 * ch + r32;
            const float u0 = gelu_erf(bf2f(Z[(size_t)row * INC + c0])), u1 = gelu_erf(bf2f(Z[(size_t)row * INC + c0 + 32]));
            MIX[(size_t)row * DM + c0] = (bf16)f2bf(u0 * (acc0[r] + bs)); MIX[(size_t)row * DM + c0 + 32] = (bf16)f2bf(u1 * (acc1[r] + bs)); }
        __syncthreads();
    }
}
__device__ __forceinline__ void ph_mixnorm(bf16* MIX, const float* g_a, const float* g_b, int gw, int NGW, int lane) {
    for (int m = gw; m < SEQ; m += NGW) {
        asm volatile("" ::: "memory");
        GAS v4u* rp = (GAS v4u*)(MIX + (size_t)m * DM) + lane; v4u w[8]; float sa = 0.f, sb = 0.f;
#pragma unroll
        for (int j = 0; j < 8; ++j) { w[j] = rp[64 * j]; const float t = (bflo(w[j].x) * bflo(w[j].x) + bfhi(w[j].x) * bfhi(w[j].x)) + (bflo(w[j].y) * bflo(w[j].y) + bfhi(w[j].y) * bfhi(w[j].y))
                + (bflo(w[j].z) * bflo(w[j].z) + bfhi(w[j].z) * bfhi(w[j].z)) + (bflo(w[j].w) * bflo(w[j].w) + bfhi(w[j].w) * bfhi(w[j].w)); if (j < 4) sa += t; else sb += t; }
        const float ra = rsqrtf(wave_sum(sa) * (1.0f / AW) + EPSN), rb = rsqrtf(wave_sum(sb) * (1.0f / BWID) + EPSN);
#pragma unroll
        for (int j = 0; j < 8; ++j) { const float r = j < 4 ? ra : rb; const float* gp = (j < 4 ? g_a + 512 * j : g_b + 512 * (j - 4)) + 8 * lane;
            const f32x4 g0 = *(const f32x4*)gp, g1 = *(const f32x4*)(gp + 4); v4u o;
            o.x = pk2(bflo(w[j].x) * r * g0.x, bfhi(w[j].x) * r * g0.y); o.y = pk2(bflo(w[j].y) * r * g0.z, bfhi(w[j].y) * r * g0.w);
            o.z = pk2(bflo(w[j].z) * r * g1.x, bfhi(w[j].z) * r * g1.y); o.w = pk2(bflo(w[j].w) * r * g1.z, bfhi(w[j].w) * r * g1.w); rp[64 * j] = o; }
    }
}
__device__ __forceinline__ void ph_postmix(const bf16* O, const float* x, const float* g_post, const float* g_pre2, const float* mods, float* out, bf16* H, LAS float* cl, int tid, int gw, int NGW, int lane) {
    for (int k = tid; k < DM; k += NWAVES * 64) { cl[k] = mods[2 * DM + k] * g_post[k]; cl[DM + k] = g_pre2[k] * (1.0f + mods[4 * DM + k]); cl[2 * DM + k] = mods[3 * DM + k]; }
    __syncthreads();
    const LAS f32x4* cA = (const LAS f32x4*)cl + lane; const LAS f32x4* cB = (const LAS f32x4*)(cl + DM) + lane; const LAS f32x4* cC = (const LAS f32x4*)(cl + 2 * DM) + lane;
    for (int m = gw; m < SEQ; m += NGW) {
        asm volatile("" ::: "memory");
        const GAS u32x2v* op = (const GAS u32x2v*)(O + (size_t)m * DM) + lane; const GAS f32x4* xp = (const GAS f32x4*)(x + (size_t)m * DM) + lane;
        f32x4 v[16]; float ss = 0.f;
#pragma unroll
        for (int j = 0; j < 16; ++j) { const u32x2v w = op[64 * j]; v[j] = (f32x4){bflo(w.x), bfhi(w.x), bflo(w.y), bfhi(w.y)}; ss += dot4(v[j]); }
        const float rstd = rsqrtf(wave_sum(ss) * (1.0f / DM) + EPSN); float s2 = 0.f;
        asm volatile("" ::: "memory");
        GAS f32x4* outp = (GAS f32x4*)(out + (size_t)m * DM) + lane;
#pragma unroll
        for (int j = 0; j < 16; ++j) { v[j] = xp[64 * j] + cA[64 * j] * (v[j] * rstd); s2 += dot4(v[j]); outp[64 * j] = v[j]; }
        const float rstd2 = rsqrtf(wave_sum(s2) * (1.0f / DM) + EPSN);
        asm volatile("" ::: "memory");
        GAS u32x2v* o8 = (GAS u32x2v*)(H + (size_t)m * DM) + lane;
#pragma unroll
        for (int j = 0; j < 16; ++j) { const f32x4 a = v[j] * rstd2 * cB[64 * j] + cC[64 * j]; u32x2v w; w.x = pk2(a.x, a.y); w.y = pk2(a.z, a.w); o8[64 * j] = w; }
    }
    __syncthreads();
}
__device__ __forceinline__ void ph_conv_fix(const float* haloP, const float* haloR, const float* cw, bf16* Gb, int gtid, int NT) {
    constexpr int NCG = (DFF / 128) * 16, NIT = (SEQ / 64) * 2 * NCG;
    for (int it = gtid; it < NIT; it += NT) {
        const int cg = it % NCG, se = it / NCG, seg = se >> 1, e = se & 1, T = cg >> 4, c8 = (cg & 15) * 8;
        const int row = seg * 64 + 63 * e, f0 = T * 128 + c8, tap = e ? 2 : 0, nseg = e ? seg + 1 : seg - 1;
        const bool valid = e ? (seg < SEQ / 64 - 1) : (seg > 0);
        const size_t hb = (size_t)se * UPC + (size_t)T * 256 + c8, nb = (size_t)(nseg * 2 + (e ? 0 : 1)) * UPC + (size_t)T * 256 + c8;
        float o[8];
#pragma unroll
        for (int h = 0; h < 2; ++h) {
            f32x4 ag = *(const f32x4*)(haloP + hb + 4 * h), au = *(const f32x4*)(haloP + hb + 128 + 4 * h);
            if (valid) { const f32x4 rg = *(const f32x4*)(haloR + nb + 4 * h), ru = *(const f32x4*)(haloR + nb + 128 + 4 * h);
                ag += *(const f32x4*)(cw + (size_t)tap * UPC + f0 + 4 * h) * rg; au += *(const f32x4*)(cw + (size_t)tap * UPC + DFF + f0 + 4 * h) * ru; }
            o[4 * h + 0] = silu_f(ag.x) * au.x; o[4 * h + 1] = silu_f(ag.y) * au.y; o[4 * h + 2] = silu_f(ag.z) * au.z; o[4 * h + 3] = silu_f(ag.w) * au.w;
        }
        v4u ov; ov.x = pk2(o[0], o[1]); ov.y = pk2(o[2], o[3]); ov.z = pk2(o[4], o[5]); ov.w = pk2(o[6], o[7]);
        *(v4u*)(Gb + (size_t)row * DFF + f0) = ov;
    }
}
__device__ __forceinline__ void ph_final(const bf16* Fm, const float* g_post, const float* mods, float* out, int gw, int NGW, int lane) {
    const f32x4* gtf = (const f32x4*)(mods + 5 * DM) + lane; const f32x4* gp = (const f32x4*)g_post + lane;
    for (int m = gw; m < SEQ; m += NGW) {
        asm volatile("" ::: "memory");
        const GAS u32x2v* fp = (const GAS u32x2v*)(Fm + (size_t)m * DM) + lane; GAS f32x4* outp = (GAS f32x4*)(out + (size_t)m * DM) + lane;
        f32x4 v[16]; float ss = 0.f;
#pragma unroll
        for (int j = 0; j < 16; ++j) { const u32x2v w = fp[64 * j]; v[j] = (f32x4){bflo(w.x), bfhi(w.x), bflo(w.y), bfhi(w.y)}; ss += dot4(v[j]); }
        const float rstd = rsqrtf(wave_sum(ss) * (1.0f / DM) + EPSN);
#pragma unroll
        for (int j = 0; j < 16; ++j) outp[64 * j] = outp[64 * j] + gtf[64 * j] * (v[j] * rstd * gp[64 * j]);
    }
}

constexpr int NPHASE = 14;
#ifndef GREP3
#define GREP3 1
#endif
#ifndef GREP10
#define GREP10 1
#endif
struct Args { const float* in[24]; float* out; unsigned char* ws; int ph_lo, ph_hi; };
__global__ void __launch_bounds__(NWAVES * 64, 2) skel_fwd(Args args) {
    extern __shared__ __attribute__((aligned(16))) unsigned char lds[];
    LAS unsigned char* ldsb = (LAS unsigned char*)lds;
    volatile LAS unsigned* MISC = (volatile LAS unsigned*)(ldsb + MISC_OFF);
    const int wave = __builtin_amdgcn_readfirstlane((int)(threadIdx.x >> 6)); __builtin_assume(wave >= 0 && wave < NWAVES);
#define lane (lane_id())
#define tid (wave * 64 + lane_id())
    const int G = gridDim.x, bid = blockIdx.x;
#define gw (bid * NWAVES + wave)
#define NGW (G * NWAVES)
    unsigned char* ws = args.ws;
    gu32* ctl = (gu32*)(ws + WS_CTL);
#define I_(k) (args.in[k])
#define Xin I_(0)
#define cvec I_(1)
#define ctx I_(2)
#define c_ctx I_(3)
#define w_ada I_(4)
#define b_ada I_(5)
#define g_pre_mix I_(6)
#define g_post_mix I_(7)
#define g_pre_ffn I_(8)
#define g_post_ffn I_(9)
#define w_in I_(10)
#define ln_v_g I_(11)
#define ln_v_b I_(12)
#define w_s I_(13)
#define b_s I_(14)
#define g_q I_(15)
#define g_k I_(16)
#define g_out_a I_(17)
#define g_out_b I_(18)
#define w_out I_(19)
#define w_up I_(20)
#define conv_w I_(21)
#define conv_b I_(22)
#define w_down I_(23)
#define out (args.out)
#define mods ((float*)(ws + WS_MODS))
#define rope ((float*)(ws + WS_ROPE))
#define lnst ((float*)(ws + WS_LNST))
#define part ((float*)(ws + WS_PART))
#define win_t ((bf16*)(ws + WS_WIN))
#define wout_t ((bf16*)(ws + WS_WOUT))
#define wup_t ((bf16*)(ws + WS_WUP))
#define wdn_t ((bf16*)(ws + WS_WDN))
#define Hb ((bf16*)(ws + WS_H))
#define Zb ((bf16*)(ws + WS_Z))
#define Qn ((bf16*)(ws + WS_Q))
#define Kn ((bf16*)(ws + WS_K))
#define Vn ((bf16*)(ws + WS_V))
#define MIX ((bf16*)(ws + WS_MIX))
#define Ob ((bf16*)(ws + WS_O))
#define haloP ((float*)(ws + WS_UP))
#define haloR ((float*)(ws + WS_UP + 24 * MiB))
#define Gb ((bf16*)(ws + WS_G))
    for (int u = tid; u < (LDS_BYTES - LDSCTL_OFF) / 4; u += NWAVES * 64) ((LAS unsigned*)(ldsb + LDSCTL_OFF))[u] = 0u;
    __syncthreads();
    XcdBarrier bar; bar.bar = (unsigned*)(ctl + CW_BAR); bar.x = 0; bar.st = nullptr;
    if (MK_ONE_LAUNCH) bar = xcd_barrier_post((unsigned*)(ctl + CW_BAR), MISC + 8);
#define GRID_BAR() do { if (MK_ONE_LAUNCH) xcd_barrier(bar); } while (0)
    const int lo = args.ph_lo, hi = args.ph_hi;
#ifndef PH_MASK
#define PH_MASK 0xFFFFF
#endif
#define IN(k) (((PH_MASK >> (k)) & 1) && lo <= (k) && (k) < hi)
#define BOTH(k) (IN(k) && IN((k) + 1))
#ifndef REPEAT_MASK
#define REPEAT_MASK 0
#endif
#define REP(k) _Pragma("unroll") for (int rep_ = 0; rep_ < (((REPEAT_MASK >> (k)) & 1) ? 2 : 1); ++rep_)

    if (IN(0)) REP(0) {
        ph_gemv(cvec, c_ctx, w_ada, part, (LAS float*)(ldsb + RING_OFF), tid, bid, G);
        ph_rope_table(rope, tid, bid);
        ph_convert<0>(w_in, w_out, w_up, w_down, win_t, wout_t, wup_t, wdn_t, gw, NGW, lane);
        if (BOTH(0)) GRID_BAR();
    }
    if (IN(1)) REP(1) { ph_mods_reduce(part, b_ada, mods, (LAS float*)(ldsb + RING_OFF), tid, bid, G); if (BOTH(1)) GRID_BAR(); }
    if (IN(2)) REP(2) { ph_prenorm(Xin, ctx, g_pre_mix, mods, Hb, gw, NGW, lane); if (BOTH(2)) GRID_BAR(); }
    if (IN(3)) REP(3) {
        pg8::Gemm g{Hb, win_t, MROWS, INC, DM}; pg8::InOrder S; S.init(G, bid); S.nrep = GREP3;
        pg8::EpiBf16<0> E{Zb, INC, nullptr, 0, 0, 1.f};
        pg8::gemm_phase<pg8::EpiBf16<0>, pg8::InOrder, PG8_ALIGN, PG8_SP2>(ldsb + RING_OFF, g, S, E, wave);
        { const int rem = (32 * 28 + 4) % G, nconv = rem ? G - rem : G;
          if (bid >= (rem ? rem : 0)) ph_convert<1>(w_in, w_out, w_up, w_down, win_t, wout_t, wup_t, wdn_t, (bid - (rem ? rem : 0)) * NWAVES + wave, nconv * NWAVES, lane); }
        if (BOTH(3)) GRID_BAR();
    }
    if (IN(4)) REP(4) { ph_qk(Zb, g_q, g_k, rope, Qn, Kn, Vn, lnst, gw, NGW, lane); if (BOTH(4)) GRID_BAR(); }
    if (IN(5)) REP(5) { ph_chunk_mlp(Zb, lnst, ln_v_g, ln_v_b, w_s, b_s, MIX, ldsb + RING_OFF, tid, bid, G); if (BOTH(5)) GRID_BAR(); }
    if (IN(6)) REP(6) {
        float mq = fmaxf(fabsf(g_q[2 * lane]), fabsf(g_q[2 * lane + 1])), mk = fmaxf(fabsf(g_k[2 * lane]), fabsf(g_k[2 * lane + 1]));
#pragma unroll
        for (int o_ = 1; o_ < 64; o_ <<= 1) { mq = fmaxf(mq, __shfl_xor(mq, o_)); mk = fmaxf(mk, __shfl_xor(mk, o_)); }
        const bool fast = __builtin_amdgcn_readfirstlane(__float_as_int(128.0f * 1.02f * attn::QSCALE * mq * mk)) <= __float_as_int(100.0f);
        for (int u = bid; u < NHQ * (SEQ / 256); u += G) {
            const int h = u >> 5, qb = u & 31;
            attn::attn_dense_body<attn::bf16>(Qn + (size_t)qb * 256 * BWID + h * HD, Kn + (h >> 2) * HD, Vn + (h >> 2) * HD, MIX + (size_t)qb * 256 * DM + AW + h * HD, MROWS, (char*)lds + RING_OFF, wave, fast);
            __syncthreads();
        }
        if (BOTH(6)) GRID_BAR();
    }
    if (IN(7)) REP(7) { ph_mixnorm(MIX, g_out_a, g_out_b, gw, NGW, lane); if (BOTH(7)) GRID_BAR(); }
    if (IN(8)) REP(8) {
        pg8::Gemm g{MIX, wout_t, SEQ, DM, DM}; pg8::StaticOrder S; S.init(SEQ, DM, G, bid);
        pg8::EpiBf16<0> E{Ob, DM, nullptr, 0, 0, 1.f};
        pg8::gemm_phase<pg8::EpiBf16<0>, pg8::StaticOrder, PG8_ALIGN, PG8_SP2>(ldsb + RING_OFF, g, S, E, wave);
        if (BOTH(8)) GRID_BAR();
    }
    if (IN(9)) REP(9) { ph_postmix(Ob, Xin, g_post_mix, g_pre_ffn, mods, out, Hb, (LAS float*)(ldsb + RING_OFF), tid, gw, NGW, lane); if (BOTH(9)) GRID_BAR(); }
    if (IN(10)) REP(10) {
        pg8::Gemm g{Hb, wup_t, SEQ, UPC, DM}; pg8::StaticOrder S; S.init(SEQ, UPC, G, bid); S.nrep = GREP10;
        pg8::EpiConvGate E{Gb, DFF, DFF, conv_w, conv_b, haloP, haloR};
        pg8::gemm_phase<pg8::EpiConvGate, pg8::StaticOrder, PG8_ALIGN, PG8_SP2>(ldsb + RING_OFF, g, S, E, wave);
        { const int rem = ((SEQ / 256) * (UPC / 256)) % G, nconv = rem ? G - rem : G;
          if (bid >= (rem ? rem : 0)) ph_convert<2>(w_in, w_out, w_up, w_down, win_t, wout_t, wup_t, wdn_t, (bid - (rem ? rem : 0)) * NWAVES + wave, nconv * NWAVES, lane); }
        if (BOTH(10)) GRID_BAR();
    }
    if (IN(11)) REP(11) { ph_conv_fix(haloP, haloR, conv_w, Gb, bid * (NWAVES * 64) + tid, G * NWAVES * 64); if (BOTH(11)) GRID_BAR(); }
    if (IN(12)) REP(12) {
        pg8::Gemm g{Gb, wdn_t, SEQ, DM, DFF}; pg8::StaticOrder S; S.init(SEQ, DM, G, bid);
        pg8::EpiBf16<0> E{Ob, DM, nullptr, 0, 0, 1.f};
        pg8::gemm_phase<pg8::EpiBf16<0>, pg8::StaticOrder, PG8_ALIGN, PG8_SP2>(ldsb + RING_OFF, g, S, E, wave);
        if (BOTH(12)) GRID_BAR();
    }
    if (IN(13)) REP(13) { ph_final(Ob, g_post_ffn, mods, out, gw, NGW, lane); }
#undef IN
#undef BOTH
#undef GRID_BAR
#undef tid
#undef lane
#undef gw
#undef NGW
#undef Xin
#undef cvec
#undef ctx
#undef c_ctx
#undef w_ada
#undef b_ada
#undef g_pre_mix
#undef g_post_mix
#undef g_pre_ffn
#undef g_post_ffn
#undef w_in
#undef ln_v_g
#undef ln_v_b
#undef w_s
#undef b_s
#undef g_q
#undef g_k
#undef g_out_a
#undef g_out_b
#undef w_out
#undef w_up
#undef conv_w
#undef conv_b
#undef w_down
#undef out
#undef mods
#undef rope
#undef lnst
#undef part
#undef win_t
#undef wout_t
#undef wup_t
#undef wdn_t
#undef Hb
#undef Zb
#undef Qn
#undef Kn
#undef Vn
#undef MIX
#undef Ob
#undef haloP
#undef haloR
#undef Gb
}

extern "C" void kernel_launch(void* const* d_in, const int* in_sizes, int n_in, void* d_out, int out_size, void* d_ws, size_t ws_size, hipStream_t stream) {
    static int grid = 0;
    if (grid == 0) {
        if (n_in != 24 || in_sizes[0] != SEQ * DM || out_size != SEQ * DM || ws_size < WS_END) { fprintf(stderr, "kernel_launch: unexpected shapes: n_in %d in0 %d out %d ws %zu (need %zu)\n", n_in, n_in > 0 ? in_sizes[0] : -1, out_size, ws_size, (size_t)WS_END); grid = -1; return; }
        int dev = 0, cus = 0, per_cu = 0;
        if (hipGetDevice(&dev) != hipSuccess || hipDeviceGetAttribute(&cus, hipDeviceAttributeMultiprocessorCount, dev) != hipSuccess) { grid = -1; return; }
        if (hipFuncSetAttribute((const void*)skel_fwd, hipFuncAttributeMaxDynamicSharedMemorySize, LDS_BYTES) != hipSuccess) { fprintf(stderr, "kernel_launch: hipFuncSetAttribute failed\n"); grid = -1; return; }
        if (hipOccupancyMaxActiveBlocksPerMultiprocessor(&per_cu, (const void*)skel_fwd, NWAVES * 64, LDS_BYTES) != hipSuccess || per_cu < 1) fprintf(stderr, "kernel_launch: occupancy query says %d\n", per_cu);
        (void)hipGetLastError();
        grid = cus;
    }
    if (grid < 0) return;
    if (hipMemsetAsync((char*)d_ws + WS_CTL, 0, CTL_ZERO_BYTES, stream) != hipSuccess) return;
    Args a{};
    for (int i = 0; i < 24; ++i) a.in[i] = (const float*)d_in[i];
    a.out = (float*)d_out; a.ws = (unsigned char*)d_ws;
#if MK_ONE_LAUNCH
    a.ph_lo = 0; a.ph_hi = NPHASE;
    hipLaunchKernelGGL(skel_fwd, dim3(grid), dim3(NWAVES * 64), LDS_BYTES, stream, a);
#else
    for (int ph = 0; ph < NPHASE; ++ph) { a.ph_lo = ph; a.ph_hi = ph + 1; hipLaunchKernelGGL(skel_fwd, dim3(grid), dim3(NWAVES * 64), LDS_BYTES, stream, a); }
#endif
    const hipError_t le = hipPeekAtLastError();
    if (le != hipSuccess) fprintf(stderr, "kernel_launch: launch failed: %s\n", hipGetErrorName(le));
}
```
